# Optimizing an MI355X kernel written in HIP

```python
import math
import jax, jax.numpy as jnp
from jax import lax
import numpy as np

D_MODEL = 1024
BATCH = 8
SEQ = 4096
DEPTH = 2

GRID_W = 64
CTX_LEN = 256
HEAD_DIM = 64
ROPE_HALF = HEAD_DIM // 4
ROPE_BASE = 10000.0
QBLOCK = 128
EPS = 1e-6
NEG_INF = -1e30
GLA_HEADS = 4
GLA_DK = 64
GLA_DV = 128
GLA_RANK = 16
GLA_TAU = 16.0
GLA_CHUNK = 64
WIN_HEADS = 8
WIN_KV = 2
WINDOW = 128
GLB_HEADS = 8
GLB_KV = 4
DIF_HEADS = 4
DIF_KV = 2
DIF_DV = 2 * HEAD_DIM
BRANCH_W = GLA_HEADS * GLA_DV
N_BRANCH = 4
IN_WIDTHS = (
    GLA_HEADS * GLA_DK, GLA_HEADS * GLA_DK, BRANCH_W, GLA_RANK, GLA_RANK, BRANCH_W,
    WIN_HEADS * HEAD_DIM, WIN_KV * HEAD_DIM, WIN_KV * HEAD_DIM, BRANCH_W,
    GLB_HEADS * HEAD_DIM, GLB_KV * HEAD_DIM, GLB_KV * HEAD_DIM, BRANCH_W,
    DIF_HEADS * 2 * HEAD_DIM, DIF_KV * 2 * HEAD_DIM, DIF_KV * DIF_DV, BRANCH_W,
)
IN_COLS = sum(IN_WIDTHS)

kernel_name = 'hybrid_gla_window_global_diff_trunk'


def ln_plain(x):
    xf = x.astype(jnp.float32)
    mu = jnp.mean(xf, axis=-1, keepdims=True)
    var = jnp.mean(jnp.square(xf - mu), axis=-1, keepdims=True)
    return ((xf - mu) * lax.rsqrt(var + EPS)).astype(x.dtype)


def ln_affine(x, g, b):
    return ln_plain(x) * g + b


def rms_norm(x, g):
    xf = x.astype(jnp.float32)
    y = xf * lax.rsqrt(jnp.mean(jnp.square(xf), axis=-1, keepdims=True) + EPS)
    return (y * g).astype(x.dtype)


def rope_2d(x, cos, sin):
    xr = x.reshape(x.shape[:-1] + (2, 2, ROPE_HALF))
    x1, x2 = xr[..., 0, :], xr[..., 1, :]
    c, s = cos.astype(x.dtype), sin.astype(x.dtype)
    return jnp.stack([x1 * c - x2 * s, x2 * c + x1 * s], axis=-2).reshape(x.shape)


def split_heads(t, n_kv, n_grp, d):
    b, l, _ = t.shape
    return t.reshape(b, l, n_kv, n_grp, d).transpose(0, 2, 3, 1, 4)


def merge_heads(o):
    b, hk, g, l, d = o.shape
    return o.transpose(0, 3, 1, 2, 4).reshape(b, l, hk * g * d)


def split_cols(p):
    parts, start = [], 0
    for w in IN_WIDTHS:
        parts.append(p[..., start:start + w])
        start += w
    return parts


def sweep_query_blocks(fn, q):
    n = q.shape[-2]
    nb = n // QBLOCK
    qb = jnp.moveaxis(q.reshape(q.shape[:-2] + (nb, QBLOCK, q.shape[-1])), -3, 0)
    out = jnp.moveaxis(lax.map(fn, qb), 0, -3)
    return out.reshape(out.shape[:-3] + (n, out.shape[-1]))


def gla_chunked(q, k, v, log_a, s0):
    b_, h_, l_, dk = q.shape
    dv = v.shape[-1]
    nc = l_ // GLA_CHUNK
    f32 = jnp.float32
    qc = q.astype(f32).reshape(b_, h_, nc, GLA_CHUNK, dk)
    kc = k.astype(f32).reshape(b_, h_, nc, GLA_CHUNK, dk)
    vc = v.astype(f32).reshape(b_, h_, nc, GLA_CHUNK, dv)
    cum = jnp.cumsum(log_a.astype(f32).reshape(b_, h_, nc, GLA_CHUNK, dk), axis=3)
    cum_last = cum[:, :, :, -1:, :]
    q_t = qc * jnp.exp(cum)
    k_t = kc * jnp.exp(-cum)
    tri = jnp.tril(jnp.ones((GLA_CHUNK, GLA_CHUNK), dtype=bool))
    a = jnp.where(tri, jnp.einsum('bhncd,bhnsd->bhncs', q_t, k_t), 0.0)
    o_intra = jnp.einsum('bhncs,bhnsv->bhncv', a, vc)
    kv = jnp.einsum('bhncd,bhncv->bhndv', kc * jnp.exp(cum_last - cum), vc)
    decay = jnp.exp(cum_last[:, :, :, 0, :])

    def step(s, inp):
        dec, kv_c = inp
        return dec[..., None] * s + kv_c, s

    _, s_starts = lax.scan(step, s0.astype(f32), (jnp.moveaxis(decay, 2, 0), jnp.moveaxis(kv, 2, 0)))
    s_starts = jnp.moveaxis(s_starts, 0, 2)
    o_inter = jnp.einsum('bhncd,bhndv->bhncv', q_t, s_starts)
    return (o_intra + o_inter).reshape(b_, h_, l_, dv)


def gla_final_state(k, v, log_a):
    cum = jnp.cumsum(log_a.astype(jnp.float32), axis=2)
    w = jnp.exp(cum[:, :, -1:, :] - cum)
    return jnp.einsum('bhld,bhlv->bhdv', k.astype(jnp.float32) * w, v.astype(jnp.float32))


def head_rms(o, g, dtype):
    of = o.astype(jnp.float32)
    y = of * lax.rsqrt(jnp.mean(jnp.square(of), axis=-1, keepdims=True) + EPS)
    b_, h_, l_, d_ = y.shape
    return (y.transpose(0, 2, 1, 3).reshape(b_, l_, h_ * d_) * g).astype(dtype)


def gla_mixer(px, pc, w_gate, b_gate, norm_g, need_ctx):
    def prep(q, k, v, g_f, g_b):
        qh = split_heads(q, GLA_HEADS, 1, GLA_DK)[:, :, 0] * (GLA_DK ** -0.5)
        kh = split_heads(k, GLA_HEADS, 1, GLA_DK)[:, :, 0]
        vh = split_heads(v, GLA_HEADS, 1, GLA_DV)[:, :, 0]
        la_f = jax.nn.log_sigmoid((g_f @ w_gate[0] + b_gate[0]).astype(jnp.float32)) / GLA_TAU
        la_b = jax.nn.log_sigmoid((g_b @ w_gate[1] + b_gate[1]).astype(jnp.float32)) / GLA_TAU
        la_f = split_heads(la_f, GLA_HEADS, 1, GLA_DK)[:, :, 0]
        la_b = split_heads(la_b, GLA_HEADS, 1, GLA_DK)[:, :, 0]
        return qh, kh, vh, la_f, la_b

    def flip(t):
        return jnp.flip(t, axis=2)

    qx, kx, vx, lfx, lbx = prep(*px)
    qc, kc, vc, lfc, lbc = prep(*pc)
    s_f = gla_final_state(kc, vc, lfc)
    s_b = gla_final_state(flip(kc), flip(vc), flip(lbc))
    o_x = gla_chunked(qx, kx, vx, lfx, s_f) + flip(gla_chunked(flip(qx), flip(kx), flip(vx), flip(lbx), s_b))
    out_x = head_rms(o_x, norm_g, px[2].dtype)
    out_c = None
    if need_ctx:
        zero = jnp.zeros_like(s_f)
        o_c = gla_chunked(qc, kc, vc, lfc, zero) + flip(gla_chunked(flip(qc), flip(kc), flip(vc), flip(lbc), zero))
        out_c = head_rms(o_c, norm_g, pc[2].dtype)
    return out_x, out_c


def window_mixer(px, pc, sink, cos, sin, need_ctx):
    grp = WIN_HEADS // WIN_KV
    scale = HEAD_DIM ** -0.5
    q = rope_2d(split_heads(px[0], WIN_KV, grp, HEAD_DIM), cos, sin) * scale
    k = rope_2d(split_heads(px[1], WIN_KV, 1, HEAD_DIM)[:, :, 0], cos, sin)
    v = split_heads(px[2], WIN_KV, 1, HEAD_DIM)[:, :, 0]
    kc = split_heads(pc[1], WIN_KV, 1, HEAD_DIM)[:, :, 0]
    vc = split_heads(pc[2], WIN_KV, 1, HEAD_DIM)[:, :, 0]
    b_, hk, _, n, d = q.shape
    nb = n // WINDOW
    nw = 3 * WINDOW
    lc = kc.shape[2]
    qb = q.reshape(b_, hk, grp, nb, WINDOW, d)
    pad = ((0, 0), (0, 0), (WINDOW, WINDOW), (0, 0))
    kp = jnp.pad(k, pad).reshape(b_, hk, nb + 2, WINDOW, d)
    vp = jnp.pad(v, pad).reshape(b_, hk, nb + 2, WINDOW, d)
    kw = jnp.concatenate([kp[:, :, :-2], kp[:, :, 1:-1], kp[:, :, 2:]], axis=3)
    vw = jnp.concatenate([vp[:, :, :-2], vp[:, :, 1:-1], vp[:, :, 2:]], axis=3)
    s_win = jnp.einsum('bhgnqd,bhnkd->bhgnqk', qb, kw).astype(jnp.float32)
    qi = jnp.arange(WINDOW)[:, None]
    kj = jnp.arange(nw)[None, :]
    key_pos = jnp.arange(nb)[:, None, None] * WINDOW - WINDOW + kj[None]
    band = (kj >= qi) & (kj <= qi + 2 * WINDOW)
    mask = band[None] & (key_pos >= 0) & (key_pos < n)
    s_win = jnp.where(mask, s_win, NEG_INF)
    s_ctx = jnp.einsum('bhgnqd,bhkd->bhgnqk', qb, kc).astype(jnp.float32)
    sink_f = sink.astype(jnp.float32).reshape(1, hk, grp, 1, 1, 1)
    s_sink = jnp.broadcast_to(sink_f, s_win.shape[:-1] + (1,))
    p = jax.nn.softmax(jnp.concatenate([s_win, s_ctx, s_sink], axis=-1), axis=-1)
    o = (jnp.einsum('bhgnqk,bhnkd->bhgnqd', p[..., :nw].astype(v.dtype), vw)
         + jnp.einsum('bhgnqk,bhkd->bhgnqd', p[..., nw:nw + lc].astype(v.dtype), vc))
    out_x = merge_heads(o.reshape(b_, hk, grp, n, d))
    out_c = None
    if need_ctx:
        qc = split_heads(pc[0], WIN_KV, grp, HEAD_DIM) * scale
        s = jnp.einsum('bhgqd,bhkd->bhgqk', qc, kc).astype(jnp.float32)
        s_sink_c = jnp.broadcast_to(sink_f[..., 0], s.shape[:-1] + (1,))
        pcx = jax.nn.softmax(jnp.concatenate([s, s_sink_c], axis=-1), axis=-1)[..., :-1]
        out_c = merge_heads(jnp.einsum('bhgqk,bhkd->bhgqd', pcx.astype(vc.dtype), vc))
    return out_x, out_c


def global_mixer(px, pc, q_gain, k_gain, cos, sin, need_ctx):
    grp = GLB_HEADS // GLB_KV
    scale = HEAD_DIM ** -0.5
    q = rope_2d(rms_norm(split_heads(px[0], GLB_KV, grp, HEAD_DIM), q_gain), cos, sin) * scale
    k = rope_2d(rms_norm(split_heads(px[1], GLB_KV, 1, HEAD_DIM)[:, :, 0], k_gain), cos, sin)
    v = split_heads(px[2], GLB_KV, 1, HEAD_DIM)[:, :, 0]
    kc = rms_norm(split_heads(pc[1], GLB_KV, 1, HEAD_DIM)[:, :, 0], k_gain)
    vc = split_heads(pc[2], GLB_KV, 1, HEAD_DIM)[:, :, 0]
    k_all = jnp.concatenate([kc, k], axis=2)
    v_all = jnp.concatenate([vc, v], axis=2)

    def block(qb):
        s = jnp.einsum('bhgqd,bhkd->bhgqk', qb, k_all).astype(jnp.float32)
        p = jax.nn.softmax(s, axis=-1)
        return jnp.einsum('bhgqk,bhkd->bhgqd', p.astype(v_all.dtype), v_all)

    out_x = merge_heads(sweep_query_blocks(block, q))
    out_c = None
    if need_ctx:
        qc = rms_norm(split_heads(pc[0], GLB_KV, grp, HEAD_DIM), q_gain) * scale
        p = jax.nn.softmax(jnp.einsum('bhgqd,bhkd->bhgqk', qc, kc).astype(jnp.float32), axis=-1)
        out_c = merge_heads(jnp.einsum('bhgqk,bhkd->bhgqd', p.astype(vc.dtype), vc))
    return out_x, out_c


def diff_mixer(px, pc, lam_p, sub_g, lam_init, cos, sin, need_ctx):
    grp = DIF_HEADS // DIF_KV
    scale = HEAD_DIM ** -0.5

    def q_heads(t):
        b_, l_, _ = t.shape
        return t.reshape(b_, l_, DIF_KV, grp, 2, HEAD_DIM).transpose(0, 2, 3, 4, 1, 5)

    def k_heads(t):
        b_, l_, _ = t.shape
        return t.reshape(b_, l_, DIF_KV, 2, HEAD_DIM).transpose(0, 2, 3, 1, 4)

    q = rope_2d(q_heads(px[0]), cos, sin) * scale
    k = rope_2d(k_heads(px[1]), cos, sin)
    v = split_heads(px[2], DIF_KV, 1, DIF_DV)[:, :, 0]
    kc = k_heads(pc[1])
    vc = split_heads(pc[2], DIF_KV, 1, DIF_DV)[:, :, 0]
    lp = lam_p.astype(jnp.float32)
    lam = jnp.exp(jnp.sum(lp[0] * lp[1])) - jnp.exp(jnp.sum(lp[2] * lp[3])) + lam_init
    k_all = jnp.concatenate([kc, k], axis=3)
    v_all = jnp.concatenate([vc, v], axis=2)

    def diff_weights(s):
        p = jax.nn.softmax(s.astype(jnp.float32), axis=-1)
        return p[:, :, :, 0] - lam * p[:, :, :, 1]

    def block(qb):
        w = diff_weights(jnp.einsum('bhgmqd,bhmkd->bhgmqk', qb, k_all))
        return jnp.einsum('bhgqk,bhkd->bhgqd', w.astype(v_all.dtype), v_all)

    o = sweep_query_blocks(block, q)
    out_x = merge_heads(rms_norm(o, sub_g) * (1.0 - lam_init))
    out_c = None
    if need_ctx:
        qc = q_heads(pc[0]) * scale
        w = diff_weights(jnp.einsum('bhgmqd,bhmkd->bhgmqk', qc, kc))
        o_c = jnp.einsum('bhgqk,bhkd->bhgqd', w.astype(vc.dtype), vc)
        out_c = merge_heads(rms_norm(o_c, sub_g) * (1.0 - lam_init))
    return out_x, out_c


def merge_branches(h, branches, w_merge, w_up, w_out):
    terms = [jax.nn.sigmoid(h @ w_merge[i]) * (o @ w_up[i]) for i, o in enumerate(branches)]
    return sum(terms[1:], terms[0]) @ w_out


def hybrid_layer(x, xc, c, c_ctx, w_ada, b_ada, w_in, gla_w_gate, gla_b_gate, gla_norm, win_sink,
                 glb_q_norm, glb_k_norm, diff_lambda, diff_norm, w_merge, w_up, w_out, ln_g, ln_b,
                 cos, sin, lam_init, need_ctx):
    alpha = (2 * DEPTH) ** 0.25
    shift_x, scale_x, gate_x = jnp.split(jax.nn.silu(c) @ w_ada + b_ada, 3, axis=-1)
    shift_c, scale_c, gate_c = jnp.split(jax.nn.silu(c_ctx) @ w_ada + b_ada, 3, axis=-1)
    h = ln_plain(x) * (1.0 + scale_x[:, None, :]) + shift_x[:, None, :]
    hc = ln_plain(xc) * (1.0 + scale_c) + shift_c
    px = split_cols(h @ w_in)
    pc = split_cols(hc @ w_in)
    oa, oca = gla_mixer(px[0:5], pc[0:5], gla_w_gate, gla_b_gate, gla_norm, need_ctx)
    ob, ocb = window_mixer(px[6:9], pc[6:9], win_sink, cos, sin, need_ctx)
    og, ocg = global_mixer(px[10:13], pc[10:13], glb_q_norm, glb_k_norm, cos, sin, need_ctx)
    od, ocd = diff_mixer(px[14:17], pc[14:17], diff_lambda, diff_norm, lam_init, cos, sin, need_ctx)
    z_idx = (5, 9, 13, 17)
    branches = [o * jax.nn.silu(px[i]) for o, i in zip((oa, ob, og, od), z_idx)]
    out_x = merge_branches(h, branches, w_merge, w_up, w_out)
    x_new = ln_affine(alpha * x + gate_x[:, None, :] * out_x, ln_g, ln_b)
    xc_new = None
    if need_ctx:
        branches_c = [o * jax.nn.silu(pc[i]) for o, i in zip((oca, ocb, ocg, ocd), z_idx)]
        out_c = merge_branches(hc, branches_c, w_merge, w_up, w_out)
        xc_new = ln_affine(alpha * xc + gate_c * out_c, ln_g, ln_b)
    return x_new, xc_new


def setup_inputs(seed: int = 0) -> dict:
    key = jax.random.key(seed)
    ks = jax.random.split(key, 20)
    f32 = jnp.float32
    L, D = DEPTH, D_MODEL
    beta = (8 * DEPTH) ** -0.25

    def nrm(k, shape, s):
        return jax.random.normal(k, shape, f32) * s

    return {
        'x': nrm(ks[0], (BATCH, SEQ, D), 1.0),
        'c': nrm(ks[1], (BATCH, D), 1.0),
        'ctx': nrm(ks[2], (BATCH, CTX_LEN, D), 1.0),
        'c_ctx': nrm(ks[3], (D,), 1.0),
        'w_ada': nrm(ks[4], (L, D, 3 * D), 0.5 * D ** -0.5),
        'b_ada': nrm(ks[5], (L, 3 * D), 0.02),
        'w_in': nrm(ks[6], (L, D, IN_COLS), D ** -0.5),
        'gla_w_gate': nrm(ks[7], (L, 2, GLA_RANK, GLA_HEADS * GLA_DK), GLA_RANK ** -0.5),
        'gla_b_gate': nrm(ks[8], (L, 2, GLA_HEADS * GLA_DK), 0.1),
        'gla_norm': 1.0 + nrm(ks[9], (L, BRANCH_W), 0.02),
        'win_sink': nrm(ks[10], (L, WIN_HEADS), 1.0),
        'glb_q_norm': 1.0 + nrm(ks[11], (L, HEAD_DIM), 0.02),
        'glb_k_norm': 1.0 + nrm(ks[12], (L, HEAD_DIM), 0.02),
        'diff_lambda': nrm(ks[13], (L, 4, HEAD_DIM), 0.1),
        'diff_norm': 1.0 + nrm(ks[14], (L, DIF_DV), 0.02),
        'w_merge': nrm(ks[15], (L, N_BRANCH, D, D), D ** -0.5),
        'w_up': nrm(ks[16], (L, N_BRANCH, BRANCH_W, D), beta * BRANCH_W ** -0.5),
        'w_out': nrm(ks[17], (L, D, D), beta * D ** -0.5),
        'ln_g': 1.0 + nrm(ks[18], (L, D), 0.02),
        'ln_b': nrm(ks[19], (L, D), 0.02),
    }


def reference(x, c, ctx, c_ctx, w_ada, b_ada, w_in, gla_w_gate, gla_b_gate, gla_norm, win_sink,
              glb_q_norm, glb_k_norm, diff_lambda, diff_norm, w_merge, w_up, w_out, ln_g, ln_b):
    n = x.shape[1]
    n_rows = n // GRID_W
    row = jnp.broadcast_to(jnp.arange(n_rows)[:, None], (n_rows, GRID_W)).reshape(n).astype(jnp.float32)
    col = jnp.broadcast_to(jnp.arange(GRID_W)[None, :], (n_rows, GRID_W)).reshape(n).astype(jnp.float32)
    freqs = ROPE_BASE ** (-jnp.arange(ROPE_HALF, dtype=jnp.float32) / ROPE_HALF)
    ang = jnp.stack([row[:, None] * freqs, col[:, None] * freqs], axis=1)
    cos, sin = jnp.cos(ang), jnp.sin(ang)
    xc = ctx
    for l in range(DEPTH):
        lam_init = 0.8 - 0.6 * math.exp(-0.3 * l)
        x, xc = hybrid_layer(x, xc, c, c_ctx, w_ada[l], b_ada[l], w_in[l], gla_w_gate[l], gla_b_gate[l],
                             gla_norm[l], win_sink[l], glb_q_norm[l], glb_k_norm[l], diff_lambda[l],
                             diff_norm[l], w_merge[l], w_up[l], w_out[l], ln_g[l], ln_b[l],
                             cos, sin, lam_init, l < DEPTH - 1)
    return x
```

```cpp
#include <hip/hip_runtime.h>
#include <hip/hip_cooperative_groups.h>
#include <cstdio>
#include <cstdint>
namespace cg = cooperative_groups;

typedef unsigned short u16;
using bf16x8 = __attribute__((ext_vector_type(8))) short;
using s16x4 = __attribute__((ext_vector_type(4))) short;
using f32x16 = __attribute__((ext_vector_type(16))) float;
using u32x4 = __attribute__((ext_vector_type(4))) unsigned;
using u32x2 = __attribute__((ext_vector_type(2))) unsigned;
typedef short v4i16_t __attribute__((ext_vector_type(4)));
typedef __attribute__((address_space(3))) const char* lds_cptr;
#define DI __device__ __forceinline__
#define MFMA(a, b, c) __builtin_amdgcn_mfma_f32_32x32x16_bf16((a), (b), (c), 0, 0, 0)

#ifndef COOP
#define COOP 1
#endif
#ifndef DUPC
#define DUPC 0
#endif
#ifndef DUPE
#define DUPE 0
#endif
#ifndef GLAREP
#define GLAREP 0
#endif
#ifndef PHM
#define PHM 0xff
#endif

constexpr int NB = 8, SEQ = 4096, LC = 256, SU = 4352, T = NB * SU, DM = 1024, PW = 5920;
constexpr float EPS = 1e-6f;
constexpr float LOG2E = 1.4426950408889634f;
constexpr float QS = 0.125f * LOG2E;
constexpr float ALPHA = 1.4142135623730951f;
constexpr int C_AQ = 0, C_AK = 256, C_AV = 512, C_AZ = 1024, C_BQ = 1536, C_BK = 2048, C_BV = 2176, C_BZ = 2304,
              C_CQ = 2816, C_CK = 3328, C_CV = 3584, C_CZ = 3840, C_DQ = 4352, C_DK = 4864, C_DV = 5120, C_DZ = 5376, C_AG = 5888;
constexpr int NWIN = 6016;
constexpr size_t OFF_P = 0;
constexpr size_t OFF_H = OFF_P + (size_t)T * PW * 2;
constexpr size_t OFF_WM = OFF_H + (size_t)T * DM * 2;
constexpr size_t OFF_WU = OFF_WM + (size_t)4 * 1024 * 1024 * 2;
constexpr size_t OFF_WO = OFF_WU + (size_t)4 * 1024 * 512 * 2;
constexpr size_t OFF_SMALL = OFF_WO + (size_t)1024 * 1024 * 2;
constexpr size_t OFF_WIN = OFF_SMALL + (1u << 20);
constexpr size_t OFF_XC1 = OFF_WIN + (size_t)NWIN * 1024 * 2;
constexpr size_t OFF_GTMP = OFF_WIN;
constexpr size_t OFF_DEC = OFF_GTMP + (size_t)T * 512 * 2;
constexpr size_t WS_NEED = OFF_DEC + (size_t)64 * 68 * 64 * 4;
constexpr size_t SM_MOD = 0;
constexpr size_t SM_TAB = 256 * 1024;
constexpr size_t SM_LAM = SM_TAB + 16 * 1024;
constexpr size_t SM_BAR = 512 * 1024;
constexpr size_t SM_CTR = SM_LAM + 256;

struct Params {
  const float *x, *c, *ctx, *c_ctx, *w_ada, *b_ada, *w_in, *gla_w_gate, *gla_b_gate, *gla_norm, *win_sink,
      *glb_q_norm, *glb_k_norm, *diff_lambda, *diff_norm, *w_merge, *w_up, *w_out, *ln_g, *ln_b;
  float* out;
  char* ws;
};

DI int otid() { int t = threadIdx.x; asm volatile("" : "+v"(t)); return t; }
DI int crow(int reg, int h) { return (reg & 3) + 8 * (reg >> 2) + 4 * h; }
typedef float f32x2_t __attribute__((ext_vector_type(2)));
typedef __bf16 bf16x2_t __attribute__((ext_vector_type(2)));
DI unsigned cvtpk(float lo, float hi) { f32x2_t v = {lo, hi}; bf16x2_t b = __builtin_convertvector(v, bf16x2_t); return __builtin_bit_cast(unsigned, b); }
DI u16 f2bf(float x) { return (u16)(cvtpk(x, 0.f) & 0xffffu); }
DI float bf2f(u16 v) { return __uint_as_float((unsigned)v << 16); }
DI float bflo(unsigned u) { return __uint_as_float(u << 16); }
DI float bfhi(unsigned u) { return __uint_as_float(u & 0xffff0000u); }
DI bf16x8 pack8(const f32x16& x, int s) {
  u32x4 p;
  p[0] = cvtpk(x[8 * s + 0], x[8 * s + 1]); p[1] = cvtpk(x[8 * s + 2], x[8 * s + 3]);
  p[2] = cvtpk(x[8 * s + 4], x[8 * s + 5]); p[3] = cvtpk(x[8 * s + 6], x[8 * s + 7]);
  return __builtin_bit_cast(bf16x8, p);
}
DI s16x4 vtr(const char* p) { return __builtin_bit_cast(s16x4, __builtin_amdgcn_ds_read_tr16_b64_v4i16((__attribute__((address_space(3))) v4i16_t*)(lds_cptr)p)); }
DI bf16x8 cat8(s16x4 lo, s16x4 hi) { return __builtin_shufflevector(lo, hi, 0, 1, 2, 3, 4, 5, 6, 7); }
DI float fexp2(float x) { return __builtin_amdgcn_exp2f(x); }
DI float sigmoidf_(float x) { return __builtin_amdgcn_rcpf(1.f + __expf(-x)); }
DI float siluf_(float x) { return x * __builtin_amdgcn_rcpf(1.f + __expf(-x)); }
DI float hsum(float v) { auto rr = __builtin_amdgcn_permlane32_swap(__float_as_uint(v), __float_as_uint(v), false, false); return __uint_as_float(rr[0]) + __uint_as_float(rr[1]); }
DI float mx2(float a, float b) { return __builtin_elementwise_maximum(a, b); }
DI float hmax(float v) { auto rr = __builtin_amdgcn_permlane32_swap(__float_as_uint(v), __float_as_uint(v), false, false); return mx2(__uint_as_float(rr[0]), __uint_as_float(rr[1])); }
DI float shx(float v, int o, int lane) { return __int_as_float(__builtin_amdgcn_ds_bpermute((lane ^ o) << 2, __float_as_int(v))); }
DI float wsum(float v, int lane) {
#pragma unroll
  for (int o = 1; o < 32; o <<= 1) v += shx(v, o, lane);
  return hsum(v);
}
DI f32x16 fzero() { f32x16 z; for (int i = 0; i < 16; ++i) z[i] = 0.f; return z; }
DI void store8pair(u16* base, int h, float a0, float a1, float a2, float a3, float b0, float b1, float b2, float b3) {
  const unsigned x0 = cvtpk(a0, a1), x1 = cvtpk(a2, a3), y0 = cvtpk(b0, b1), y1 = cvtpk(b2, b3);
  auto r0 = __builtin_amdgcn_permlane32_swap(x0, y0, false, false);
  auto r1 = __builtin_amdgcn_permlane32_swap(x1, y1, false, false);
  u32x4 v; v[0] = r0[0]; v[1] = r1[0]; v[2] = r0[1]; v[3] = r1[1];
  *(u32x4*)(base + 8 * h) = v;
}
DI void load8pair(const u16* base, int h, u32x2& x, u32x2& y) {
  const u32x4 v = *(const u32x4*)(base + 8 * h);
  auto r0 = __builtin_amdgcn_permlane32_swap(v[0], v[2], false, false);
  auto r1 = __builtin_amdgcn_permlane32_swap(v[1], v[3], false, false);
  x[0] = r0[0]; x[1] = r1[0]; y[0] = r0[1]; y[1] = r1[1];
}
DI void store4bf(u16* dst, float a, float b, float c, float d) { u32x2 v; v[0] = cvtpk(a, b); v[1] = cvtpk(c, d); *(u32x2*)dst = v; }

template <int TJ>
DI void gemm_core(const u16* __restrict__ W, int ldw, const u16* __restrict__ X, int ldx, int K, f32x16 (&acc)[2][TJ], char* lds) {
  constexpr int XR = 64 * TJ;
  constexpr int WBYTES = 128 * 64, XBYTES = XR * 64, STAGE = WBYTES + XBYTES;
  const int tid = otid(), lane = tid & 63, wid = tid >> 6, r = lane & 31, h = lane >> 5;
  const int wn = wid & 1, wt = wid >> 1;
  u32x4 wA[2], xA[TJ], wB[2], xB[TJ];
  const int lrow = tid >> 2, lch = tid & 3;
  const u16* wp = W + (size_t)lrow * ldw + lch * 8;
  const u16* xp = X + (size_t)lrow * ldx + lch * 8;
  const int nk = K / 32;
#define G_LOAD(wr, xr, kt_)                                                                                     \
  {                                                                                                             \
    _Pragma("unroll") for (int it = 0; it < 2; ++it) wr[it] = *(const u32x4*)(wp + (size_t)(64 * it) * ldw + (kt_) * 32);  \
    _Pragma("unroll") for (int it = 0; it < TJ; ++it) xr[it] = *(const u32x4*)(xp + (size_t)(64 * it) * ldx + (kt_) * 32); \
  }
#define G_STORE(wr, xr, buf_)                                                                                   \
  {                                                                                                             \
    char* nb_ = lds + (buf_) * STAGE;                                                                           \
    _Pragma("unroll") for (int it = 0; it < 2; ++it) { int row = lrow + 64 * it; *(u32x4*)(nb_ + lch * (128 * 16) + ((row ^ (2 * lch)) * 16)) = wr[it]; }          \
    _Pragma("unroll") for (int it = 0; it < TJ; ++it) { int row = lrow + 64 * it; *(u32x4*)(nb_ + WBYTES + lch * (XR * 16) + ((row ^ (2 * lch)) * 16)) = xr[it]; } \
  }
#define G_COMPUTE(buf_)                                                                                         \
  {                                                                                                             \
    const char* base = lds + (buf_) * STAGE;                                                                    \
    _Pragma("unroll") for (int s = 0; s < 2; ++s) {                                                             \
      const int ch = 2 * s + h;                                                                                 \
      bf16x8 wf[2], xf[TJ];                                                                                     \
      _Pragma("unroll") for (int i = 0; i < 2; ++i) { int row = wn * 64 + 32 * i + r; wf[i] = *(const bf16x8*)(base + ch * 2048 + ((row ^ (2 * ch)) * 16)); } \
      _Pragma("unroll") for (int j = 0; j < TJ; ++j) { int row = wt * (32 * TJ) + 32 * j + r; xf[j] = *(const bf16x8*)(base + WBYTES + ch * (XR * 16) + ((row ^ (2 * ch)) * 16)); } \
      __builtin_amdgcn_s_setprio(1);                                                                            \
      _Pragma("unroll") for (int i = 0; i < 2; ++i)                                                             \
        _Pragma("unroll") for (int j = 0; j < TJ; ++j) acc[i][j] = MFMA(wf[i], xf[j], acc[i][j]);              \
      __builtin_amdgcn_s_setprio(0);                                                                            \
    }                                                                                                           \
  }
  G_LOAD(wA, xA, 0);
  G_LOAD(wB, xB, 1);
  G_STORE(wA, xA, 0);
  __syncthreads();
  for (int kt = 0; kt < nk; kt += 2) {
    if (kt + 2 < nk) G_LOAD(wA, xA, kt + 2);
    G_COMPUTE(0);
    G_STORE(wB, xB, 1);
    __syncthreads();
    if (kt + 3 < nk) G_LOAD(wB, xB, kt + 3);
    G_COMPUTE(1);
    if (kt + 2 < nk) G_STORE(wA, xA, 0);
    __syncthreads();
  }
#undef G_LOAD
#undef G_STORE
#undef G_COMPUTE
}

DI void tconv_tile(const float* __restrict__ src, int ns, int K, int k0, int n0, int srccol0, int nvalid, u16* __restrict__ dst, char* lds) {
  float* tl = (float*)lds;
  const int tid = otid();
  const int j4 = (tid & 15) * 4, i0 = tid >> 4;
#pragma unroll
  for (int it = 0; it < 4; ++it) {
    int i = i0 + 16 * it;
    float4 v = make_float4(0.f, 0.f, 0.f, 0.f);
    if (srccol0 >= 0 && j4 < nvalid) v = *(const float4*)(src + (size_t)(k0 + i) * ns + srccol0 + j4);
    tl[i * 65 + j4 + 0] = v.x; tl[i * 65 + j4 + 1] = v.y; tl[i * 65 + j4 + 2] = v.z; tl[i * 65 + j4 + 3] = v.w;
  }
  __syncthreads();
  const int n = tid >> 2, kq = (tid & 3) * 16;
  u32x4 o0, o1;
#pragma unroll
  for (int e = 0; e < 4; ++e) {
    o0[e] = cvtpk(tl[(kq + 2 * e) * 65 + n], tl[(kq + 2 * e + 1) * 65 + n]);
    o1[e] = cvtpk(tl[(kq + 8 + 2 * e) * 65 + n], tl[(kq + 8 + 2 * e + 1) * 65 + n]);
  }
  u16* d = dst + (size_t)(n0 + n) * K + k0 + kq;
  *(u32x4*)d = o0; *(u32x4*)(d + 8) = o1;
  __syncthreads();
}

DI void weights_item(const Params& p, int layer, int item, char* lds) {
  if (item < 1504) {
    int nt = item >> 4, kt = item & 15;
    int n0 = nt * 64, sc, nv = 64;
    if (n0 < 1024) sc = n0; else if (n0 < 5888) sc = n0 + 32; else if (n0 == 5888) { sc = 1024; nv = 32; } else sc = -1;
    tconv_tile(p.w_in + (size_t)layer * 1024 * 5920, 5920, 1024, kt * 64, n0, sc, nv, (u16*)(p.ws + OFF_WIN), lds);
  } else if (item < 2528) {
    int id = item - 1504; int br = id >> 8, nt = (id >> 4) & 15, kt = id & 15;
    tconv_tile(p.w_merge + ((size_t)layer * 4 + br) * 1024 * 1024, 1024, 1024, kt * 64, nt * 64, nt * 64, 64, (u16*)(p.ws + OFF_WM) + (size_t)br * 1024 * 1024, lds);
  } else if (item < 3040) {
    int id = item - 2528; int br = id >> 7, nt = (id >> 3) & 15, kt = id & 7;
    tconv_tile(p.w_up + ((size_t)layer * 4 + br) * 512 * 1024, 1024, 512, kt * 64, nt * 64, nt * 64, 64, (u16*)(p.ws + OFF_WU) + (size_t)br * 1024 * 512, lds);
  } else {
    int id = item - 3040; int nt = id >> 4, kt = id & 15;
    tconv_tile(p.w_out + (size_t)layer * 1024 * 1024, 1024, 1024, kt * 64, nt * 64, nt * 64, 64, (u16*)(p.ws + OFF_WO), lds);
  }
}

DI void adaln_item(const Params& p, int item, char* lds) {
  const int layer = item / 96, j0 = (item % 96) * 32;
  float* sl = (float*)lds;
  const int tid = otid();
  for (int e = tid; e < 9 * 1024; e += 256) { int rr = e >> 10, k = e & 1023; float v = rr < 8 ? p.c[rr * 1024 + k] : p.c_ctx[k]; sl[e] = siluf_(v); }
  __syncthreads();
  const int c4 = tid & 7, ks = tid >> 3;
  float a[9][4];
#pragma unroll
  for (int rr = 0; rr < 9; ++rr) { a[rr][0] = 0.f; a[rr][1] = 0.f; a[rr][2] = 0.f; a[rr][3] = 0.f; }
  const float* wp = p.w_ada + (size_t)layer * 1024 * 3072 + j0 + c4 * 4;
#pragma unroll 8
  for (int i = 0; i < 32; ++i) {
    const int k = i * 32 + ks;
    const float4 w = *(const float4*)(wp + (size_t)k * 3072);
#pragma unroll
    for (int rr = 0; rr < 9; ++rr) {
      const float sv = sl[rr * 1024 + k];
      a[rr][0] += sv * w.x; a[rr][1] += sv * w.y; a[rr][2] += sv * w.z; a[rr][3] += sv * w.w;
    }
  }
  __syncthreads();
  float* red = sl;
#pragma unroll
  for (int rr = 0; rr < 9; ++rr) *(float4*)(red + (ks * 9 + rr) * 32 + c4 * 4) = make_float4(a[rr][0], a[rr][1], a[rr][2], a[rr][3]);
  __syncthreads();
  float* mod = (float*)(p.ws + OFF_SMALL + SM_MOD);
  for (int e = tid; e < 9 * 32; e += 256) {
    int rr = e >> 5, cc = e & 31; float sacc = p.b_ada[layer * 3072 + j0 + cc];
#pragma unroll 8
    for (int q = 0; q < 32; ++q) sacc += red[(q * 9 + rr) * 32 + cc];
    mod[((size_t)layer * 9 + rr) * 3072 + j0 + cc] = sacc;
  }
  __syncthreads();
}

DI void misc_item(const Params& p) {
  const int tid = otid();
  float2* tab = (float2*)(p.ws + OFF_SMALL + SM_TAB);
  for (int e = tid; e < 1024; e += 256) {
    int pos = e >> 4, f = e & 15;
    float freq = powf(10000.0f, -(float)f / 16.0f);
    float ang = (float)pos * freq;
    tab[e] = make_float2(cosf(ang), sinf(ang));
  }
  if (tid < 96) ((int*)(p.ws + OFF_SMALL + SM_CTR))[tid] = 0;
  if (tid < 2) {
    const float* lp = p.diff_lambda + tid * 256;
    float s1 = 0.f, s2 = 0.f;
    for (int d = 0; d < 64; ++d) { s1 += lp[d] * lp[64 + d]; s2 += lp[128 + d] * lp[192 + d]; }
    float li = tid == 0 ? 0.2f : 0.35550906759096927f;
    ((float*)(p.ws + OFF_SMALL + SM_LAM))[tid] = expf(s1) - expf(s2) + li;
  }
}

DI void ln_rows(const Params& p, int layer) {
  const int tid = otid(), lane = tid & 63, wid = tid >> 6;
  const float* mod = (const float*)(p.ws + OFF_SMALL + SM_MOD) + (size_t)layer * 9 * 3072;
  u16* H = (u16*)(p.ws + OFF_H);
  float* xc1 = (float*)(p.ws + OFF_XC1);
  for (int row = blockIdx.x * 4 + wid; row < T; row += gridDim.x * 4) {
    const int b = row / SU, s = row % SU;
    const float* src; float* dst;
    const float* md;
    if (s < LC) { const size_t off = ((size_t)b * LC + s) * DM; src = p.ctx + off; dst = xc1 + off; md = mod + 8 * 3072; }
    else { const size_t off = ((size_t)b * SEQ + s - LC) * DM; src = p.x + off; dst = p.out + off; md = mod + b * 3072; }
    float4 v[4];
#pragma unroll
    for (int i = 0; i < 4; ++i) v[i] = *(const float4*)(src + i * 256 + lane * 4);
    if (layer == 1) {
      const u16* up = (const u16*)(p.ws + OFF_P) + (size_t)row * PW + 1024;
#pragma unroll
      for (int i = 0; i < 4; ++i) {
        const u32x2 uu = *(const u32x2*)(up + i * 256 + lane * 4);
        v[i].x = ALPHA * v[i].x + bflo(uu[0]); v[i].y = ALPHA * v[i].y + bfhi(uu[0]);
        v[i].z = ALPHA * v[i].z + bflo(uu[1]); v[i].w = ALPHA * v[i].w + bfhi(uu[1]);
      }
      float sm = 0.f;
#pragma unroll
      for (int i = 0; i < 4; ++i) sm += v[i].x + v[i].y + v[i].z + v[i].w;
      sm = wsum(sm, lane);
      const float mu = sm * (1.f / 1024.f);
      float sq = 0.f;
#pragma unroll
      for (int i = 0; i < 4; ++i) { float a = v[i].x - mu, bq = v[i].y - mu, cq = v[i].z - mu, d = v[i].w - mu; sq += a * a + bq * bq + cq * cq + d * d; }
      sq = wsum(sq, lane);
      const float rstd = rsqrtf(sq * (1.f / 1024.f) + EPS);
#pragma unroll
      for (int i = 0; i < 4; ++i) {
        float4 g = *(const float4*)(p.ln_g + i * 256 + lane * 4), be = *(const float4*)(p.ln_b + i * 256 + lane * 4);
        v[i].x = (v[i].x - mu) * rstd * g.x + be.x; v[i].y = (v[i].y - mu) * rstd * g.y + be.y;
        v[i].z = (v[i].z - mu) * rstd * g.z + be.z; v[i].w = (v[i].w - mu) * rstd * g.w + be.w;
        *(float4*)(dst + i * 256 + lane * 4) = v[i];
      }
    }
    float sm = 0.f;
#pragma unroll
    for (int i = 0; i < 4; ++i) sm += v[i].x + v[i].y + v[i].z + v[i].w;
    sm = wsum(sm, lane);
    const float mu = sm * (1.f / 1024.f);
    float sq = 0.f;
#pragma unroll
    for (int i = 0; i < 4; ++i) { float a = v[i].x - mu, bq = v[i].y - mu, cq = v[i].z - mu, d = v[i].w - mu; sq += a * a + bq * bq + cq * cq + d * d; }
    sq = wsum(sq, lane);
    const float rstd = rsqrtf(sq * (1.f / 1024.f) + EPS);
#pragma unroll
    for (int i = 0; i < 4; ++i) {
      const int cidx = i * 256 + lane * 4;
      float4 sh = *(const float4*)(md + cidx), sc = *(const float4*)(md + 1024 + cidx);
      float a = (v[i].x - mu) * rstd * (1.f + sc.x) + sh.x, bq = (v[i].y - mu) * rstd * (1.f + sc.y) + sh.y;
      float cq = (v[i].z - mu) * rstd * (1.f + sc.z) + sh.z, d = (v[i].w - mu) * rstd * (1.f + sc.w) + sh.w;
      store4bf(H + (size_t)row * DM + cidx, a, bq, cq, d);
    }
  }
}

DI void final_ln(const Params& p) {
  const int tid = otid(), lane = tid & 63, wid = tid >> 6;
  const float* g_ = p.ln_g + 1024; const float* b_ = p.ln_b + 1024;
  for (int row = blockIdx.x * 4 + wid; row < NB * SEQ; row += gridDim.x * 4) {
    float* src = p.out + (size_t)row * DM;
    const u16* up = (const u16*)(p.ws + OFF_P) + ((size_t)(row >> 12) * SU + LC + (row & 4095)) * PW + 1024;
    float4 v[4];
#pragma unroll
    for (int i = 0; i < 4; ++i) {
      v[i] = *(const float4*)(src + i * 256 + lane * 4);
      const u32x2 uu = *(const u32x2*)(up + i * 256 + lane * 4);
      v[i].x = ALPHA * v[i].x + bflo(uu[0]); v[i].y = ALPHA * v[i].y + bfhi(uu[0]);
      v[i].z = ALPHA * v[i].z + bflo(uu[1]); v[i].w = ALPHA * v[i].w + bfhi(uu[1]);
    }
    float sm = 0.f;
#pragma unroll
    for (int i = 0; i < 4; ++i) sm += v[i].x + v[i].y + v[i].z + v[i].w;
    sm = wsum(sm, lane);
    const float mu = sm * (1.f / 1024.f);
    float sq = 0.f;
#pragma unroll
    for (int i = 0; i < 4; ++i) { float a = v[i].x - mu, bq = v[i].y - mu, cq = v[i].z - mu, d = v[i].w - mu; sq += a * a + bq * bq + cq * cq + d * d; }
    sq = wsum(sq, lane);
    const float rstd = rsqrtf(sq * (1.f / 1024.f) + EPS);
#pragma unroll
    for (int i = 0; i < 4; ++i) {
      float4 g = *(const float4*)(g_ + i * 256 + lane * 4), be = *(const float4*)(b_ + i * 256 + lane * 4);
      v[i].x = (v[i].x - mu) * rstd * g.x + be.x; v[i].y = (v[i].y - mu) * rstd * g.y + be.y;
      v[i].z = (v[i].z - mu) * rstd * g.z + be.z; v[i].w = (v[i].w - mu) * rstd * g.w + be.w;
      *(float4*)(src + i * 256 + lane * 4) = v[i];
    }
  }
}

DI void phase_inproj(const Params& p, int layer, char* lds) {
  const u16* Wt = (const u16*)(p.ws + OFF_WIN); const u16* H = (const u16*)(p.ws + OFF_H); u16* P = (u16*)(p.ws + OFF_P);
  const float2* tab = (const float2*)(p.ws + OFF_SMALL + SM_TAB);
  const int tid = otid(), lane = tid & 63, wid = tid >> 6, r = lane & 31, h = lane >> 5;
  const int wn = wid & 1, wt = wid >> 1;
  const int xcd = blockIdx.x & 7, li = blockIdx.x >> 3, nloc = gridDim.x >> 3;
  for (int q = li; q < 6 * 17 * 8; q += nloc) {
    const int ni = q & 7, a = (q >> 3) % 17, ng = (q >> 3) / 17;
    const int tt = 8 * a + xcd, nt = ng * 8 + ni;
    if (nt >= 47) continue;
    f32x16 acc[2][4];
#pragma unroll
    for (int i = 0; i < 2; ++i)
#pragma unroll
      for (int j = 0; j < 4; ++j) acc[i][j] = fzero();
    gemm_core<4>(Wt + (size_t)nt * 128 * 1024, 1024, H + (size_t)tt * 256 * 1024, 1024, 1024, acc, lds);
    const int u = nt * 2 + wn;
    if (u >= 93) continue;
    bool rope = false; const float* gain = nullptr; float scl = 1.f;
    if (u < 4) scl = 0.125f;
    else if (u >= 24 && u < 32) { rope = true; scl = QS; }
    else if (u >= 32 && u < 34) rope = true;
    else if (u >= 44 && u < 52) { rope = true; scl = QS; gain = p.glb_q_norm + layer * 64; }
    else if (u >= 52 && u < 56) { rope = true; gain = p.glb_k_norm + layer * 64; }
    else if (u >= 68 && u < 76) { rope = true; scl = QS; }
    else if (u >= 76 && u < 80) rope = true;
    const int s0 = (tt % 17) * 256;
    const bool isx = s0 >= LC;
#pragma unroll
    for (int j = 0; j < 4; ++j) {
      const int t2_ = otid();
      const int tl = (t2_ >> 7) * 128 + 32 * j + (t2_ & 31);
      const size_t tok = (size_t)tt * 256 + tl;
      if (gain) {
        float ss = 0.f;
#pragma unroll
        for (int i = 0; i < 2; ++i)
#pragma unroll
          for (int reg = 0; reg < 16; ++reg) ss += acc[i][j][reg] * acc[i][j][reg];
        ss = hsum(ss);
        const float inv = rsqrtf(ss * (1.f / 64.f) + EPS);
#pragma unroll
        for (int i = 0; i < 2; ++i)
#pragma unroll
          for (int reg = 0; reg < 16; ++reg) acc[i][j][reg] *= inv * gain[32 * i + crow(reg, h)];
      }
      if (rope && isx) {
        const int t = s0 - LC + tl;
        const int prow = t >> 6, pcol = t & 63;
#pragma unroll
        for (int i = 0; i < 2; ++i) {
          const int pos = i == 0 ? prow : pcol;
#pragma unroll
          for (int reg = 0; reg < 8; ++reg) {
            const float2 cs = tab[pos * 16 + crow(reg, h)];
            const float x1 = acc[i][j][reg], x2 = acc[i][j][reg + 8];
            acc[i][j][reg] = x1 * cs.x - x2 * cs.y;
            acc[i][j][reg + 8] = x2 * cs.x + x1 * cs.y;
          }
        }
      }
#pragma unroll
      for (int i = 0; i < 2; ++i) {
        if (u == 92 && i == 1) continue;
#pragma unroll
        for (int k2 = 0; k2 < 2; ++k2) {
          u16* dst = P + tok * PW + u * 64 + 32 * i + 16 * k2;
          store8pair(dst, h, acc[i][j][8 * k2] * scl, acc[i][j][8 * k2 + 1] * scl, acc[i][j][8 * k2 + 2] * scl, acc[i][j][8 * k2 + 3] * scl,
                     acc[i][j][8 * k2 + 4] * scl, acc[i][j][8 * k2 + 5] * scl, acc[i][j][8 * k2 + 6] * scl, acc[i][j][8 * k2 + 7] * scl);
        }
      }
    }
  }
}

DI void stage_q(const u16* qptr, char* lds) {
  const int tid = otid(), lane = tid & 63, r = lane & 31, h = lane >> 5;
  char* qlds = lds + 49152 + (tid >> 6) * 4096;
  bf16x8 q[4];
#pragma unroll
  for (int s = 0; s < 4; ++s) q[s] = *(const bf16x8*)(qptr + 16 * s + 8 * h);
#pragma unroll
  for (int s = 0; s < 4; ++s) { const int ch = 2 * s + h; *(bf16x8*)(qlds + ch * 512 + ((r ^ ch) * 16)) = q[s]; }
}
template <int DV>
DI void attn_core(const u16* __restrict__ P, size_t tokbase, int kcol, int vcol, int n1, int n2, int xs0,
                  bool win, int tq, float m0, float l0, f32x16 (&o)[DV / 32], float& lsum, char* lds) {
  constexpr int KB = 8192, VB = 64 * DV * 2, STAGE = KB + VB;
  constexpr int NVL = DV / 32, VSH = (DV == 64 ? 3 : 4);
  constexpr float THR = 6.f;
  const int tid = otid(), lane = tid & 63, r = lane & 31, h = lane >> 5;
  const char* qlds = lds + 49152 + (tid >> 6) * 4096;
  bf16x8 qreg[4];
#pragma unroll
  for (int s = 0; s < 4; ++s) { const int ch = 2 * s + h; qreg[s] = *(const bf16x8*)(qlds + ch * 512 + ((r ^ ch) * 16)); }
  u32x4 kA[2], vA[NVL], kB[2], vB[NVL];
  const int ntiles = n1 + n2;
  const int kkey = tid >> 3, kch = tid & 7;
  const int vkey = tid >> VSH, vpc = tid & ((1 << VSH) - 1);
  const int vstep = 256 >> VSH;
  const bool autoinit = (l0 == 0.f);
  float m = autoinit ? 0.f : m0, l = (h == 0) ? l0 : 0.f;
  f32x16 negm;
#pragma unroll
  for (int reg = 0; reg < 16; ++reg) negm[reg] = -m;
#pragma unroll
  for (int b = 0; b < DV / 32; ++b) o[b] = fzero();
  const int trofs = (4 * h + ((lane & 15) >> 2)) * 64 + ((lane >> 4) & 1) * 32 + (lane & 3) * 8;
#define A_LOAD(kr, vr, t_)                                                                                          \
  {                                                                                                                 \
    const int s0_ = ((t_) < n1) ? (t_) * 64 : xs0 + ((t_) - n1) * 64;                                               \
    const u16* kb_ = P + (tokbase + s0_) * PW;                                                                      \
    _Pragma("unroll") for (int i = 0; i < 2; ++i) kr[i] = *(const u32x4*)(kb_ + (size_t)(kkey + 32 * i) * PW + kcol + kch * 8);        \
    _Pragma("unroll") for (int i = 0; i < NVL; ++i) vr[i] = *(const u32x4*)(kb_ + (size_t)(vkey + vstep * i) * PW + vcol + vpc * 8);  \
  }
#define A_STORE(kr, vr, buf_)                                                                                       \
  {                                                                                                                 \
    char* nb_ = lds + (buf_) * STAGE;                                                                               \
    _Pragma("unroll") for (int i = 0; i < 2; ++i) { int key = kkey + 32 * i; *(u32x4*)(nb_ + kch * 1024 + ((key ^ kch) * 16)) = kr[i]; }   \
    _Pragma("unroll") for (int i = 0; i < NVL; ++i) { int key = vkey + vstep * i; *(u32x4*)(nb_ + KB + (vpc >> 2) * 4096 + key * 64 + (vpc & 3) * 16) = vr[i]; } \
  }
  auto compute = [&](const char* base, int it) __attribute__((always_inline)) {
    const bool domask = win && it >= n1;
    const int kt0 = xs0 + (it - n1) * 64 - LC;
#pragma unroll
    for (int ks = 0; ks < 2; ++ks) {
      f32x16 pt = negm;
#pragma unroll
      for (int s = 0; s < 4; ++s) {
        const int ch = 2 * s + h, key = 32 * ks + r;
        const bf16x8 kf = *(const bf16x8*)(base + ch * 1024 + ((key ^ ch) * 16));
        const bf16x8 qf = qreg[s];
        pt = MFMA(kf, qf, pt);
      }
      if (domask) {
#pragma unroll
        for (int reg = 0; reg < 16; ++reg) {
          const int d = tq - (kt0 + 32 * ks + crow(reg, h));
          if (d > 128 || d < -128) pt[reg] = -1e30f;
        }
      }
      float mloc = mx2(pt[0], pt[1]);
#pragma unroll
      for (int reg = 2; reg < 16; reg += 2) mloc = mx2(mx2(mloc, pt[reg]), pt[reg + 1]);
      mloc = hmax(mloc);
      const bool first = autoinit && it == 0 && ks == 0;
      if (first || __builtin_amdgcn_ballot_w64(mloc > THR) != 0) {
        const float d = first ? mloc : fmaxf(mloc, 0.f);
        const float alpha = fexp2(-d);
        m += d; l *= alpha;
#pragma unroll
        for (int reg = 0; reg < 16; ++reg) { negm[reg] = -m; pt[reg] -= d; }
#pragma unroll
        for (int b = 0; b < DV / 32; ++b)
#pragma unroll
          for (int reg = 0; reg < 16; ++reg) o[b][reg] *= alpha;
      }
      float la = 0.f;
#pragma unroll
      for (int reg = 0; reg < 16; ++reg) { const float e = fexp2(pt[reg]); pt[reg] = e; la += e; }
      l += la;
#pragma unroll
      for (int s2 = 0; s2 < 2; ++s2) {
        const bf16x8 pb = pack8(pt, s2);
        const int s16 = 2 * ks + s2;
#pragma unroll
        for (int b = 0; b < DV / 32; ++b) {
          const char* va = base + KB + b * 4096 + s16 * 1024 + trofs;
          const bf16x8 vf = cat8(vtr(va), vtr(va + 512));
          o[b] = MFMA(vf, pb, o[b]);
        }
      }
    }
  };
  if (DV == 64) {
    A_LOAD(kA, vA, 0);
    A_LOAD(kB, vB, 1);
    A_STORE(kA, vA, 0);
    __syncthreads();
    for (int it = 0; it < ntiles; it += 2) {
      if (it + 2 < ntiles) A_LOAD(kA, vA, it + 2);
      compute(lds, it);
      A_STORE(kB, vB, 1);
      __syncthreads();
      if (it + 3 < ntiles) A_LOAD(kB, vB, it + 3);
      compute(lds + STAGE, it + 1);
      if (it + 2 < ntiles) A_STORE(kA, vA, 0);
      __syncthreads();
    }
  } else {
    A_LOAD(kA, vA, 0);
    A_STORE(kA, vA, 0);
    __syncthreads();
    for (int it = 0; it < ntiles; it += 2) {
      A_LOAD(kA, vA, it + 1);
      compute(lds, it);
      A_STORE(kA, vA, 1);
      __syncthreads();
      if (it + 2 < ntiles) A_LOAD(kA, vA, it + 2);
      compute(lds + STAGE, it + 1);
      if (it + 2 < ntiles) A_STORE(kA, vA, 0);
      __syncthreads();
    }
  }
#undef A_LOAD
#undef A_STORE
  lsum = hsum(l);
}

#define PROW() (P + (tokbase + qs0 + (otid() >> 6) * 32 + (otid() & 31)) * PW)
DI void attn_item(const Params& p, int layer, int kind, int b, int hq, int qs0, char* lds) {
  u16* P = (u16*)(p.ws + OFF_P);
  const int tid = otid(), lane = tid & 63, wid = tid >> 6, r = lane & 31, h = lane >> 5;
  const size_t tokbase = (size_t)b * SU;
  const int sq = qs0 + wid * 32 + r;
  const bool isctx = qs0 < LC;
  if (kind == 2) {
    const int hk = hq >> 1;
    const float lam = ((const float*)(p.ws + OFF_SMALL + SM_LAM))[layer];
    const float li = layer == 0 ? 0.2f : 0.35550906759096927f;
    const int n1 = isctx ? 4 : 68;
#define O1G() (PROW() + C_DQ + hq * 128)
    {
      f32x16 o[4]; float ls;
      stage_q(PROW() + C_DQ + (hq * 2 + 0) * 64, lds);
      attn_core<128>(P, tokbase, C_DK + (hk * 2 + 0) * 64, C_DV + hk * 128, n1, 0, 0, false, 0, -1e30f, 0.f, o, ls, lds);
      const float inv = 1.f / ls;
      stage_q(PROW() + C_DQ + (hq * 2 + 1) * 64, lds);
#pragma unroll
      for (int bk = 0; bk < 4; ++bk)
#pragma unroll
        for (int k2 = 0; k2 < 2; ++k2)
          store8pair(O1G() + 32 * bk + 16 * k2, h, o[bk][8 * k2] * inv, o[bk][8 * k2 + 1] * inv, o[bk][8 * k2 + 2] * inv, o[bk][8 * k2 + 3] * inv,
                     o[bk][8 * k2 + 4] * inv, o[bk][8 * k2 + 5] * inv, o[bk][8 * k2 + 6] * inv, o[bk][8 * k2 + 7] * inv);
    }
    f32x16 o[4]; float ls;
    attn_core<128>(P, tokbase, C_DK + (hk * 2 + 1) * 64, C_DV + hk * 128, n1, 0, 0, false, 0, -1e30f, 0.f, o, ls, lds);
    const float inv2 = lam / ls;
    float ss = 0.f;
#pragma unroll
    for (int bk = 0; bk < 4; ++bk)
#pragma unroll
      for (int k2 = 0; k2 < 2; ++k2) {
        u32x2 tx, ty;
        load8pair(O1G() + 32 * bk + 16 * k2, h, tx, ty);
#pragma unroll
        for (int gg = 0; gg < 2; ++gg) {
          const u32x2 t1 = gg == 0 ? tx : ty;
          const int g4 = 2 * k2 + gg;
          const float a0 = bflo(t1[0]) - o[bk][4 * g4] * inv2, a1 = bfhi(t1[0]) - o[bk][4 * g4 + 1] * inv2;
          const float a2 = bflo(t1[1]) - o[bk][4 * g4 + 2] * inv2, a3 = bfhi(t1[1]) - o[bk][4 * g4 + 3] * inv2;
          o[bk][4 * g4] = a0; o[bk][4 * g4 + 1] = a1; o[bk][4 * g4 + 2] = a2; o[bk][4 * g4 + 3] = a3;
          ss += a0 * a0 + a1 * a1 + a2 * a2 + a3 * a3;
        }
      }
    ss = hsum(ss);
    const float rn = rsqrtf(ss * (1.f / 128.f) + EPS) * (1.f - li);
    const float* sg = p.diff_norm + layer * 128;
#pragma unroll
    for (int bk = 0; bk < 4; ++bk)
#pragma unroll
      for (int k2 = 0; k2 < 2; ++k2) {
        u16* zp = PROW() + C_DZ + hq * 128 + 32 * bk + 16 * k2;
        u32x2 zx, zy;
        load8pair(zp, h, zx, zy);
        const float4 gx = *(const float4*)(sg + 32 * bk + 16 * k2 + 4 * h), gy = *(const float4*)(sg + 32 * bk + 16 * k2 + 8 + 4 * h);
        store8pair(zp, h, o[bk][8 * k2] * rn * gx.x * siluf_(bflo(zx[0])), o[bk][8 * k2 + 1] * rn * gx.y * siluf_(bfhi(zx[0])),
                   o[bk][8 * k2 + 2] * rn * gx.z * siluf_(bflo(zx[1])), o[bk][8 * k2 + 3] * rn * gx.w * siluf_(bfhi(zx[1])),
                   o[bk][8 * k2 + 4] * rn * gy.x * siluf_(bflo(zy[0])), o[bk][8 * k2 + 5] * rn * gy.y * siluf_(bfhi(zy[0])),
                   o[bk][8 * k2 + 6] * rn * gy.z * siluf_(bflo(zy[1])), o[bk][8 * k2 + 7] * rn * gy.w * siluf_(bfhi(zy[1])));
        __builtin_amdgcn_sched_barrier(0);
      }
  } else {
    int qc, kc, vc, zc, n1, n2 = 0, xs0 = 0; bool win = false; float m0 = -1e30f, l0 = 0.f;
    if (kind == 1) { qc = C_CQ + hq * 64; kc = C_CK + (hq >> 1) * 64; vc = C_CV + (hq >> 1) * 64; zc = C_CZ + hq * 64; n1 = isctx ? 4 : 68; }
    else {
      qc = C_BQ + hq * 64; kc = C_BK + (hq >> 2) * 64; vc = C_BV + (hq >> 2) * 64; zc = C_BZ + hq * 64; n1 = 4;
      m0 = p.win_sink[layer * 8 + hq] * LOG2E; l0 = 1.f;
      if (!isctx) {
        const int q0 = qs0 - LC;
        const int lo = q0 - 128 < 0 ? 0 : q0 - 128, hi = q0 + 256 > SEQ ? SEQ : q0 + 256;
        xs0 = LC + lo; n2 = (hi - lo) >> 6; win = true;
      }
    }
    f32x16 o[2]; float ls;
    stage_q(PROW() + qc, lds);
    attn_core<64>(P, tokbase, kc, vc, n1, n2, xs0, win, sq - LC, m0, l0, o, ls, lds);
    const float inv = 1.f / ls;
#pragma unroll
    for (int bk = 0; bk < 2; ++bk)
#pragma unroll
      for (int k2 = 0; k2 < 2; ++k2) {
        u16* zp = PROW() + zc + 32 * bk + 16 * k2;
        u32x2 zx, zy;
        load8pair(zp, h, zx, zy);
        store8pair(zp, h, o[bk][8 * k2] * inv * siluf_(bflo(zx[0])), o[bk][8 * k2 + 1] * inv * siluf_(bfhi(zx[0])),
                   o[bk][8 * k2 + 2] * inv * siluf_(bflo(zx[1])), o[bk][8 * k2 + 3] * inv * siluf_(bfhi(zx[1])),
                   o[bk][8 * k2 + 4] * inv * siluf_(bflo(zy[0])), o[bk][8 * k2 + 5] * inv * siluf_(bfhi(zy[0])),
                   o[bk][8 * k2 + 6] * inv * siluf_(bflo(zy[1])), o[bk][8 * k2 + 7] * inv * siluf_(bfhi(zy[1])));
        __builtin_amdgcn_sched_barrier(0);
      }
  }
}

#undef PROW
#undef O1G
DI void attn_core2(const u16* __restrict__ P, size_t tokbase, int kcol, int vcol, int n1, int n2, int xs0, bool win, int tq0,
                   float m0, float l0, const bf16x8 (&qreg)[2][4], f32x16 (&o)[2][2], float (&lsum)[2], char* lds) {
  constexpr int KB = 8192, STAGE = 16384;
  constexpr float THR = 12.f;
  const int tid = otid(), lane = tid & 63, r = lane & 31, h = lane >> 5;
  u32x4 kA[2], vA[2];
  const int ntiles = n1 + n2;
  const int kkey = tid >> 3, kch = tid & 7;
  const bool autoinit = (l0 == 0.f);
  float m[2], l[2];
  bool mz[2];
#pragma unroll
  for (int qs = 0; qs < 2; ++qs) { m[qs] = autoinit ? 0.f : m0; mz[qs] = autoinit; l[qs] = (h == 0) ? l0 : 0.f; o[qs][0] = fzero(); o[qs][1] = fzero(); }
  const int trofs = (4 * h + ((lane & 15) >> 2)) * 64 + ((lane >> 4) & 1) * 32 + (lane & 3) * 8;
#define A_LOAD(kr, vr, t_)                                                                                          \
  {                                                                                                                 \
    const int s0_ = ((t_) < n1) ? (t_) * 64 : xs0 + ((t_) - n1) * 64;                                               \
    const u16* kb_ = P + (tokbase + s0_) * PW;                                                                      \
    _Pragma("unroll") for (int i = 0; i < 2; ++i) kr[i] = *(const u32x4*)(kb_ + (size_t)(kkey + 32 * i) * PW + kcol + kch * 8);  \
    _Pragma("unroll") for (int i = 0; i < 2; ++i) vr[i] = *(const u32x4*)(kb_ + (size_t)(kkey + 32 * i) * PW + vcol + kch * 8);  \
  }
#define A_STORE(kr, vr, buf_)                                                                                       \
  {                                                                                                                 \
    char* nb_ = lds + (buf_) * STAGE;                                                                               \
    _Pragma("unroll") for (int i = 0; i < 2; ++i) { int key = kkey + 32 * i; *(u32x4*)(nb_ + kch * 1024 + ((key ^ kch) * 16)) = kr[i]; }   \
    _Pragma("unroll") for (int i = 0; i < 2; ++i) { int key = kkey + 32 * i; *(u32x4*)(nb_ + KB + (kch >> 2) * 4096 + key * 64 + (kch & 3) * 16) = vr[i]; } \
  }
  auto compute = [&](const char* base, int it) __attribute__((always_inline)) {
    const bool domask = win && it >= n1;
    const int kt0 = xs0 + (it - n1) * 64 - LC;
#pragma unroll
    for (int ks = 0; ks < 2; ++ks) {
      f32x16 pt[2]; pt[0] = fzero(); pt[1] = fzero();
#pragma unroll
      for (int s = 0; s < 4; ++s) {
        const int ch = 2 * s + h, key = 32 * ks + r;
        const bf16x8 kf = *(const bf16x8*)(base + ch * 1024 + ((key ^ ch) * 16));
        pt[0] = MFMA(kf, qreg[0][s], pt[0]);
        pt[1] = MFMA(kf, qreg[1][s], pt[1]);
      }
#pragma unroll
      for (int qs = 0; qs < 2; ++qs) {
        if (domask) {
#pragma unroll
          for (int reg = 0; reg < 16; ++reg) {
            const int d = tq0 + 32 * qs - (kt0 + 32 * ks + crow(reg, h));
            if (d > 128 || d < -128) pt[qs][reg] = -1e30f;
          }
        }
        float mloc = mx2(pt[qs][0], pt[qs][1]);
#pragma unroll
        for (int reg = 2; reg < 16; reg += 2) mloc = mx2(mx2(mloc, pt[qs][reg]), pt[qs][reg + 1]);
        mloc = hmax(mloc) - m[qs];
        if (__builtin_amdgcn_ballot_w64(mloc > THR) != 0) {
          const float d = fmaxf(mloc, 0.f);
          const float alpha = fexp2(-d);
          m[qs] += d; l[qs] *= alpha; mz[qs] = false;
#pragma unroll
          for (int b = 0; b < 2; ++b)
#pragma unroll
            for (int reg = 0; reg < 16; ++reg) o[qs][b][reg] *= alpha;
        }
        float la = 0.f;
        if (mz[qs]) {
#pragma unroll
          for (int reg = 0; reg < 16; ++reg) { const float e = fexp2(pt[qs][reg]); pt[qs][reg] = e; la += e; }
        } else {
#pragma unroll
          for (int reg = 0; reg < 16; ++reg) { const float e = fexp2(pt[qs][reg] - m[qs]); pt[qs][reg] = e; la += e; }
        }
        l[qs] += la;
      }
#pragma unroll
      for (int s2 = 0; s2 < 2; ++s2) {
        const bf16x8 pb0 = pack8(pt[0], s2), pb1 = pack8(pt[1], s2);
        const int s16 = 2 * ks + s2;
#pragma unroll
        for (int b = 0; b < 2; ++b) {
          const char* va = base + KB + b * 4096 + s16 * 1024 + trofs;
          const bf16x8 vf = cat8(vtr(va), vtr(va + 512));
          o[0][b] = MFMA(vf, pb0, o[0][b]);
          o[1][b] = MFMA(vf, pb1, o[1][b]);
        }
      }
    }
  };
  A_LOAD(kA, vA, 0);
  A_STORE(kA, vA, 0);
  __syncthreads();
  for (int it = 0; it < ntiles; it += 2) {
    A_LOAD(kA, vA, it + 1);
    compute(lds, it);
    A_STORE(kA, vA, 1);
    __syncthreads();
    if (it + 2 < ntiles) A_LOAD(kA, vA, it + 2);
    compute(lds + STAGE, it + 1);
    if (it + 2 < ntiles) A_STORE(kA, vA, 0);
    __syncthreads();
  }
#undef A_LOAD
#undef A_STORE
  lsum[0] = hsum(l[0]); lsum[1] = hsum(l[1]);
}

DI void attn_item2(const Params& p, int layer, int kind, int b, int hq, int qs0, char* lds) {
  u16* P = (u16*)(p.ws + OFF_P);
  const int tid = otid(), lane = tid & 63, wid = tid >> 6, r = lane & 31, h = lane >> 5;
  const size_t tokbase = (size_t)b * SU;
  const bool isctx = qs0 < LC;
#define PROW2(qs_) (P + (tokbase + qs0 + (otid() >> 6) * 64 + 32 * (qs_) + (otid() & 31)) * PW)
  int qc, kc, vc, zc, n1, n2 = 0, xs0 = 0; bool win = false; float m0 = -1e30f, l0 = 0.f;
  if (kind == 1) { qc = C_CQ + hq * 64; kc = C_CK + (hq >> 1) * 64; vc = C_CV + (hq >> 1) * 64; zc = C_CZ + hq * 64; n1 = isctx ? 4 : 68; }
  else {
    qc = C_BQ + hq * 64; kc = C_BK + (hq >> 2) * 64; vc = C_BV + (hq >> 2) * 64; zc = C_BZ + hq * 64; n1 = 4;
    m0 = p.win_sink[layer * 8 + hq] * LOG2E; l0 = 1.f;
    if (!isctx) {
      const int q0 = qs0 - LC;
      const int lo = q0 - 128 < 0 ? 0 : q0 - 128, hi = q0 + 384 > SEQ ? SEQ : q0 + 384;
      xs0 = LC + lo; n2 = (hi - lo) >> 6; win = true;
    }
  }
  bf16x8 qreg[2][4];
  {
    const char* qlds = lds + 49152 + wid * 4096;
#pragma unroll
    for (int qs = 0; qs < 2; ++qs) {
      stage_q(PROW2(qs) + qc, lds);
#pragma unroll
      for (int s = 0; s < 4; ++s) { const int ch = 2 * s + h; qreg[qs][s] = *(const bf16x8*)(qlds + ch * 512 + ((r ^ ch) * 16)); }
    }
  }
  __syncthreads();
  f32x16 o[2][2]; float ls[2];
  attn_core2(P, tokbase, kc, vc, n1, n2, xs0, win, qs0 + wid * 64 + r - LC, m0, l0, qreg, o, ls, lds);
#pragma unroll
  for (int qs = 0; qs < 2; ++qs) {
    const float inv = 1.f / ls[qs];
#pragma unroll
    for (int bk = 0; bk < 2; ++bk)
#pragma unroll
      for (int k2 = 0; k2 < 2; ++k2) {
        u16* zp = PROW2(qs) + zc + 32 * bk + 16 * k2;
        u32x2 zx, zy;
        load8pair(zp, h, zx, zy);
        store8pair(zp, h, o[qs][bk][8 * k2] * inv * siluf_(bflo(zx[0])), o[qs][bk][8 * k2 + 1] * inv * siluf_(bfhi(zx[0])),
                   o[qs][bk][8 * k2 + 2] * inv * siluf_(bflo(zx[1])), o[qs][bk][8 * k2 + 3] * inv * siluf_(bfhi(zx[1])),
                   o[qs][bk][8 * k2 + 4] * inv * siluf_(bflo(zy[0])), o[qs][bk][8 * k2 + 5] * inv * siluf_(bfhi(zy[0])),
                   o[qs][bk][8 * k2 + 6] * inv * siluf_(bflo(zy[1])), o[qs][bk][8 * k2 + 7] * inv * siluf_(bfhi(zy[1])));
        __builtin_amdgcn_sched_barrier(0);
      }
  }
#undef PROW2
}

DI void gla_prep(const Params& p, int layer, int b, int hd, int c, char* lds) {
  u16* P = (u16*)(p.ws + OFF_P);
  u16* TMP = (u16*)(p.ws + OFF_GTMP);
  float* DECG = (float*)(p.ws + OFF_DEC);
  const int tid = otid();
  float* G = (float*)lds;
  float* WG = (float*)(lds + 8192);
  float* LAF = (float*)(lds + 17408);
  float* LAB = (float*)(lds + 33792);
  float* CS = (float*)(lds + 50176);
  const size_t tokbase = (size_t)b * SU + 64 * c;
  for (int e = tid; e < 2048; e += 256) { const int d = e >> 10, rr = (e >> 6) & 15, k = e & 63; WG[e] = p.gla_w_gate[(size_t)((layer * 2 + d) * 16 + rr) * 256 + hd * 64 + k]; }
  if (tid < 128) WG[2048 + tid] = p.gla_b_gate[(layer * 2 + (tid >> 6)) * 256 + hd * 64 + (tid & 63)];
  {
    const int tok = tid >> 2, part = tid & 3;
    const u32x4 gv = *(const u32x4*)(P + (tokbase + tok) * PW + C_AG + part * 8);
    float* gp = G + tok * 32 + part * 8;
    *(float4*)gp = make_float4(bflo(gv[0]), bfhi(gv[0]), bflo(gv[1]), bfhi(gv[1]));
    *(float4*)(gp + 4) = make_float4(bflo(gv[2]), bfhi(gv[2]), bflo(gv[3]), bfhi(gv[3]));
  }
  const int tp = tid >> 3, cg8 = (tid & 7) * 8;
  u32x4 qv[2], kv[2];
#pragma unroll
  for (int t = 0; t < 2; ++t) {
    const u16* rp = P + (tokbase + 2 * tp + t) * PW + hd * 64 + cg8;
    qv[t] = *(const u32x4*)(rp + C_AQ); kv[t] = *(const u32x4*)(rp + C_AK);
  }
  __syncthreads();
#pragma unroll
  for (int t = 0; t < 2; ++t) {
    const int tok = 2 * tp + t;
    float pf[8], pb[8];
    {
      const float4 b0 = *(const float4*)(WG + 2048 + cg8), b1 = *(const float4*)(WG + 2048 + cg8 + 4);
      const float4 c0 = *(const float4*)(WG + 2112 + cg8), c1 = *(const float4*)(WG + 2112 + cg8 + 4);
      pf[0] = b0.x; pf[1] = b0.y; pf[2] = b0.z; pf[3] = b0.w; pf[4] = b1.x; pf[5] = b1.y; pf[6] = b1.z; pf[7] = b1.w;
      pb[0] = c0.x; pb[1] = c0.y; pb[2] = c0.z; pb[3] = c0.w; pb[4] = c1.x; pb[5] = c1.y; pb[6] = c1.z; pb[7] = c1.w;
    }
#pragma unroll 4
    for (int rr = 0; rr < 16; ++rr) {
      const float gf = G[tok * 32 + rr], gb = G[tok * 32 + 16 + rr];
      const float4 w0 = *(const float4*)(WG + rr * 64 + cg8), w1 = *(const float4*)(WG + rr * 64 + cg8 + 4);
      const float4 v0 = *(const float4*)(WG + 1024 + rr * 64 + cg8), v1 = *(const float4*)(WG + 1024 + rr * 64 + cg8 + 4);
      pf[0] += gf * w0.x; pf[1] += gf * w0.y; pf[2] += gf * w0.z; pf[3] += gf * w0.w; pf[4] += gf * w1.x; pf[5] += gf * w1.y; pf[6] += gf * w1.z; pf[7] += gf * w1.w;
      pb[0] += gb * v0.x; pb[1] += gb * v0.y; pb[2] += gb * v0.z; pb[3] += gb * v0.w; pb[4] += gb * v1.x; pb[5] += gb * v1.y; pb[6] += gb * v1.z; pb[7] += gb * v1.w;
    }
#pragma unroll
    for (int e = 0; e < 8; ++e) {
      pf[e] = (fminf(pf[e], 0.f) - __logf(1.f + __expf(-fabsf(pf[e])))) * (1.f / 16.f);
      pb[e] = (fminf(pb[e], 0.f) - __logf(1.f + __expf(-fabsf(pb[e])))) * (1.f / 16.f);
    }
    *(float4*)(LAF + tok * 64 + cg8) = make_float4(pf[0], pf[1], pf[2], pf[3]); *(float4*)(LAF + tok * 64 + cg8 + 4) = make_float4(pf[4], pf[5], pf[6], pf[7]);
    *(float4*)(LAB + tok * 64 + cg8) = make_float4(pb[0], pb[1], pb[2], pb[3]); *(float4*)(LAB + tok * 64 + cg8 + 4) = make_float4(pb[4], pb[5], pb[6], pb[7]);
  }
  __syncthreads();
  {
    const int ch = tid & 63, q4 = tid >> 6;
    float run = 0.f;
#pragma unroll
    for (int i = 0; i < 16; ++i) { run += LAF[(16 * q4 + i) * 64 + ch]; LAF[(16 * q4 + i) * 64 + ch] = run; }
    CS[q4 * 64 + ch] = run;
    run = 0.f;
#pragma unroll
    for (int i = 15; i >= 0; --i) { run += LAB[(16 * q4 + i) * 64 + ch]; LAB[(16 * q4 + i) * 64 + ch] = run; }
    CS[256 + q4 * 64 + ch] = run;
  }
  __syncthreads();
  {
    const int qq = tp >> 3;
    float pre_f[8], pre_b[8], tot_f[8], tot_b[8];
#pragma unroll
    for (int e = 0; e < 8; ++e) { pre_f[e] = 0.f; pre_b[e] = 0.f; tot_f[e] = 0.f; tot_b[e] = 0.f; }
#pragma unroll
    for (int q = 0; q < 4; ++q) {
#pragma unroll
      for (int e = 0; e < 8; ++e) {
        const float vf_ = CS[q * 64 + cg8 + e], vb_ = CS[256 + q * 64 + cg8 + e];
        tot_f[e] += vf_; tot_b[e] += vb_;
        if (q < qq) pre_f[e] += vf_;
        if (q > qq) pre_b[e] += vb_;
      }
    }
#pragma unroll
    for (int t = 0; t < 2; ++t) {
      const int tok = 2 * tp + t;
      u32x4 oqf, okf, oqb, okb;
#pragma unroll
      for (int e2 = 0; e2 < 4; ++e2) {
        const float q0 = bflo(qv[t][e2]), q1 = bfhi(qv[t][e2]), k0 = bflo(kv[t][e2]), k1 = bfhi(kv[t][e2]);
        const float cf0 = pre_f[2 * e2] + LAF[tok * 64 + cg8 + 2 * e2], cf1 = pre_f[2 * e2 + 1] + LAF[tok * 64 + cg8 + 2 * e2 + 1];
        const float cb0 = pre_b[2 * e2] + LAB[tok * 64 + cg8 + 2 * e2], cb1 = pre_b[2 * e2 + 1] + LAB[tok * 64 + cg8 + 2 * e2 + 1];
        oqf[e2] = cvtpk(q0 * __expf(cf0), q1 * __expf(cf1)); okf[e2] = cvtpk(k0 * __expf(-cf0), k1 * __expf(-cf1));
        oqb[e2] = cvtpk(q0 * __expf(cb0), q1 * __expf(cb1)); okb[e2] = cvtpk(k0 * __expf(-cb0), k1 * __expf(-cb1));
        __builtin_amdgcn_sched_barrier(0);
      }
      u16* pf_ = P + (tokbase + tok) * PW + hd * 64 + cg8;
      u16* pb_ = TMP + (tokbase + tok) * 512 + hd * 64 + cg8;
      *(u32x4*)(pf_ + C_AQ) = oqf; *(u32x4*)(pf_ + C_AK) = okf;
      *(u32x4*)pb_ = oqb; *(u32x4*)(pb_ + 256) = okb;
    }
    if (tp == 0) {
#pragma unroll
      for (int e = 0; e < 8; ++e) {
        DECG[((size_t)((b * 4 + hd) * 2 + 0) * 68 + c) * 64 + cg8 + e] = expf(tot_f[e]);
        DECG[((size_t)((b * 4 + hd) * 2 + 1) * 68 + c) * 64 + cg8 + e] = expf(tot_b[e]);
      }
    }
  }
  __syncthreads();
}

DI void gla_chain(const Params& p, int layer, int b, int hd, int dir, char* lds) {
  u16* P = (u16*)(p.ws + OFF_P);
  const u16* TMP = (const u16*)(p.ws + OFF_GTMP);
  const float* DECG = (const float*)(p.ws + OFF_DEC) + (size_t)((b * 4 + hd) * 2 + dir) * 68 * 64;
  const int tid = otid(), lane = tid & 63, w = tid >> 6, r = lane & 31, h = lane >> 5;
  char* QT = lds; char* KT = lds + 9216; char* KH = lds + 18432; char* VV = lds + 26624; float* DEC = (float*)(lds + 43008);
  const size_t tokbase = (size_t)b * SU;
  const u16* qsrc = dir == 0 ? P + C_AQ + hd * 64 : TMP + hd * 64;
  const u16* ksrc = dir == 0 ? P + C_AK + hd * 64 : TMP + 256 + hd * 64;
  const int qst = dir == 0 ? PW : 512;
  const u16* vsrc = P + C_AV + hd * 128;
  u16* odst = P + (dir == 0 ? C_DQ : C_DK) + hd * 128;
  const int trofs = (4 * h + ((lane & 15) >> 2)) * 64 + ((lane >> 4) & 1) * 32 + (lane & 3) * 8;
  f32x16 S[2]; S[0] = fzero(); S[1] = fzero();
  u32x4 rq[2], rk[2], rv[4]; float rdec = 0.f;
  const int sdir = dir == 0 ? 1 : -1;
#define GLA_LOAD(n_)                                                                                               \
  {                                                                                                                \
    const int c_ = dir == 0 ? (n_) : ((n_) < 4 ? 3 - (n_) : 71 - (n_));                                              \
    const int sb_ = dir == 0 ? 64 * c_ : 64 * c_ + 63;                                                             \
    _Pragma("unroll") for (int it = 0; it < 2; ++it) {                                                             \
      const int id = tid + 256 * it, tok = id >> 3, pc = id & 7;                                                   \
      const size_t row = tokbase + sb_ + sdir * tok;                                                               \
      rq[it] = *(const u32x4*)(qsrc + row * qst + pc * 8);                                                         \
      rk[it] = *(const u32x4*)(ksrc + row * qst + pc * 8);                                                         \
    }                                                                                                              \
    _Pragma("unroll") for (int it = 0; it < 4; ++it) {                                                             \
      const int id = tid + 256 * it, tok = id >> 4, pc = id & 15;                                                  \
      rv[it] = *(const u32x4*)(vsrc + (tokbase + sb_ + sdir * tok) * PW + pc * 8);                                 \
    }                                                                                                              \
    if (tid < 64) rdec = DECG[c_ * 64 + tid];                                                                      \
  }
  GLA_LOAD(0);
  for (int n = 0; n < 68; ++n) {
    int nopq = n; asm volatile("" : "+s"(nopq));
    const int c = dir == 0 ? nopq : (nopq < 4 ? 3 - nopq : 71 - nopq);
    const int sbase = dir == 0 ? 64 * c : 64 * c + 63;
    __syncthreads();
#pragma unroll
    for (int it = 0; it < 2; ++it) {
      const int id = tid + 256 * it, tok = id >> 3, pc = id & 7;
      *(u32x4*)(QT + tok * 144 + pc * 16) = rq[it];
      *(u32x4*)(KT + tok * 144 + pc * 16) = rk[it];
      *(u32x4*)(KH + (pc >> 2) * 4096 + tok * 64 + (pc & 3) * 16) = rk[it];
    }
#pragma unroll
    for (int it = 0; it < 4; ++it) {
      const int id = tid + 256 * it, tok = id >> 4, pc = id & 15;
      *(u32x4*)(VV + (pc >> 2) * 4096 + tok * 64 + (pc & 3) * 16) = rv[it];
    }
    if (tid < 64) DEC[tid] = rdec;
    __syncthreads();
    if (n + 1 < 68) GLA_LOAD(nopq + 1);
    bf16x8 qf[2][4];
#pragma unroll
    for (int cs = 0; cs < 2; ++cs)
#pragma unroll
      for (int sp = 0; sp < 4; ++sp) {
        const char* a = QT + (32 * cs + r) * 144 + (16 * sp + 4 * h) * 2;
        qf[cs][sp] = cat8(*(const s16x4*)a, *(const s16x4*)(a + 16));
      }
    bf16x8 vf[4];
#pragma unroll
    for (int s16 = 0; s16 < 4; ++s16) { const char* va = VV + w * 4096 + s16 * 1024 + trofs; vf[s16] = cat8(vtr(va), vtr(va + 512)); }
    f32x16 o0 = fzero(), o1 = fzero();
#pragma unroll
    for (int tix = 0; tix < 3; ++tix) {
      const int ssub = tix == 2 ? 1 : 0, csub = tix == 0 ? 0 : 1;
      f32x16 at = fzero();
#pragma unroll
      for (int sp = 0; sp < 4; ++sp) {
        const char* a0 = KT + (32 * ssub + r) * 144 + (16 * sp + 4 * h) * 2;
        const bf16x8 kf0 = cat8(*(const s16x4*)a0, *(const s16x4*)(a0 + 16));
        at = MFMA(kf0, qf[csub][sp], at);
      }
      if (ssub == csub) {
#pragma unroll
        for (int reg = 0; reg < 16; ++reg) if (crow(reg, h) > r) at[reg] = 0.f;
      }
#pragma unroll
      for (int s2 = 0; s2 < 2; ++s2) {
        if (csub == 0) o0 = MFMA(vf[2 * ssub + s2], pack8(at, s2), o0);
        else o1 = MFMA(vf[2 * ssub + s2], pack8(at, s2), o1);
      }
    }
#pragma unroll
    for (int i = 0; i < 2; ++i)
#pragma unroll
      for (int s2 = 0; s2 < 2; ++s2) {
        const bf16x8 sp8 = pack8(S[i], s2);
        o0 = MFMA(sp8, qf[0][2 * i + s2], o0);
        o1 = MFMA(sp8, qf[1][2 * i + s2], o1);
      }
#pragma unroll
    for (int i = 0; i < 2; ++i) {
#pragma unroll
      for (int s16 = 0; s16 < 4; ++s16) {
        const char* ka = KH + i * 4096 + s16 * 1024 + trofs;
        const bf16x8 khf = cat8(vtr(ka), vtr(ka + 512));
        S[i] = MFMA(khf, vf[s16], S[i]);
      }
#pragma unroll
      for (int g4 = 0; g4 < 4; ++g4) {
        const float4 d4 = *(const float4*)(DEC + 32 * i + 8 * g4 + 4 * h);
        S[i][4 * g4] *= d4.x; S[i][4 * g4 + 1] *= d4.y; S[i][4 * g4 + 2] *= d4.z; S[i][4 * g4 + 3] *= d4.w;
      }
    }
    int lo_ = lane; asm volatile("" : "+v"(lo_));
    const int r2 = lo_ & 31, h2 = lo_ >> 5;
#pragma unroll
    for (int cs = 0; cs < 2; ++cs) {
      const f32x16& oo = cs == 0 ? o0 : o1;
      const size_t tok = tokbase + sbase + sdir * (32 * cs + r2);
#pragma unroll
      for (int k2 = 0; k2 < 2; ++k2)
        store8pair(odst + tok * PW + 32 * w + 16 * k2, h2, oo[8 * k2], oo[8 * k2 + 1], oo[8 * k2 + 2], oo[8 * k2 + 3], oo[8 * k2 + 4], oo[8 * k2 + 5], oo[8 * k2 + 6], oo[8 * k2 + 7]);
    }
  }
#undef GLA_LOAD
  asm volatile("s_waitcnt vmcnt(0)" ::: "memory");
  __syncthreads();
  if (tid == 0) {
    __builtin_amdgcn_fence(__ATOMIC_RELEASE, "agent");
    asm volatile("s_waitcnt vmcnt(0)" ::: "memory");
    __hip_atomic_fetch_add((int*)(p.ws + OFF_SMALL + SM_CTR) + 32 + layer * 32 + b * 4 + hd, 1, __ATOMIC_RELAXED, __HIP_MEMORY_SCOPE_AGENT);
  }
}

DI void gla_combine(const Params& p, int layer, int b, int hd, int tile, char* lds) {
  u16* P = (u16*)(p.ws + OFF_P);
  const int tid = otid();
  int* flag = (int*)(p.ws + OFF_SMALL + SM_CTR) + 32 + layer * 32 + b * 4 + hd;
  if (tid == 0) {
    while (__hip_atomic_load(flag, __ATOMIC_RELAXED, __HIP_MEMORY_SCOPE_AGENT) < 2) __builtin_amdgcn_s_sleep(8);
    __builtin_amdgcn_fence(__ATOMIC_ACQUIRE, "agent");
    asm volatile("s_waitcnt vmcnt(0)" ::: "memory");
  }
  __syncthreads();
  const int sub = tid & 15, tl = tid >> 4, lane = tid & 63;
  const float* ng = p.gla_norm + layer * 512 + hd * 128 + sub * 8;
  const float4 g0 = *(const float4*)ng, g1 = *(const float4*)(ng + 4);
#pragma unroll 2
  for (int ps = 0; ps < 8; ++ps) {
    u16* row = P + ((size_t)b * SU + tile * 128 + ps * 16 + tl) * PW + hd * 128 + sub * 8;
    const u32x4 a = *(const u32x4*)(row + C_DQ), bq = *(const u32x4*)(row + C_DK), z = *(const u32x4*)(row + C_AZ);
    float v[8]; float ss = 0.f;
#pragma unroll
    for (int k = 0; k < 4; ++k) {
      v[2 * k] = bflo(a[k]) + bflo(bq[k]); v[2 * k + 1] = bfhi(a[k]) + bfhi(bq[k]);
      ss += v[2 * k] * v[2 * k] + v[2 * k + 1] * v[2 * k + 1];
    }
    ss += shx(ss, 1, lane); ss += shx(ss, 2, lane); ss += shx(ss, 4, lane); ss += shx(ss, 8, lane);
    const float rn = rsqrtf(ss * (1.f / 128.f) + EPS);
    u32x4 o;
    o[0] = cvtpk(v[0] * rn * g0.x * siluf_(bflo(z[0])), v[1] * rn * g0.y * siluf_(bfhi(z[0])));
    o[1] = cvtpk(v[2] * rn * g0.z * siluf_(bflo(z[1])), v[3] * rn * g0.w * siluf_(bfhi(z[1])));
    o[2] = cvtpk(v[4] * rn * g1.x * siluf_(bflo(z[2])), v[5] * rn * g1.y * siluf_(bfhi(z[2])));
    o[3] = cvtpk(v[6] * rn * g1.z * siluf_(bflo(z[3])), v[7] * rn * g1.w * siluf_(bfhi(z[3])));
    *(u32x4*)(row + C_AZ) = o;
  }
}

DI void phase_mix(const Params& p, int layer, int sub, char* lds) {
  int& s_item = *(int*)(lds + 65536);
  int* ctrs = (int*)(p.ws + OFF_SMALL + SM_CTR) + (layer * 2 + sub) * 8;
  const int total = sub == 0 ? (layer == 0 ? 272 + 128 + 24 : 272 + 128) : 8 + 256 + 136;
  for (int qi = 0; qi < 8; ++qi) {
    const int b = (blockIdx.x + qi) & 7;
    for (;;) {
      if (threadIdx.x == 0) s_item = atomicAdd(ctrs + b, 1);
      __syncthreads();
      const int item = s_item;
      __syncthreads();
      if (item >= total) break;
      if (sub == 0) {
        if (item < 272) gla_prep(p, layer, b, item / 68, item % 68, lds);
        else if (item < 400) { const int id = item - 272; attn_item(p, layer, 2, b, id >> 5, LC + (id & 31) * 128, lds); }
        else if (item < 408) { const int id = item - 400; attn_item(p, layer, 2, b, id >> 1, (id & 1) * 128, lds); }
        else if (item < 416) attn_item2(p, layer, 1, b, item - 408, 0, lds);
        else attn_item2(p, layer, 0, b, item - 416, 0, lds);
      } else {
        if (item < 8) gla_chain(p, layer, b, item & 3, item < 4 ? 1 : 0, lds);
        else if (item < 136) { const int id = item - 8; attn_item2(p, layer, 1, b, id >> 4, LC + (id & 15) * 256, lds); }
        else if (item < 264) { const int id = item - 136; attn_item2(p, layer, 0, b, id >> 4, LC + (id & 15) * 256, lds); }
        else { const int id = item - 264; gla_combine(p, layer, b, id / 34, id % 34, lds); }
      }
    }
  }
}

template <int TJ>
DI void merge_tile(const Params& p, size_t t0, int nt, char* lds) {
  const u16* Wm = (const u16*)(p.ws + OFF_WM); const u16* Wu = (const u16*)(p.ws + OFF_WU);
  const u16* H = (const u16*)(p.ws + OFF_H); u16* P = (u16*)(p.ws + OFF_P);
  const int tid = otid(), lane = tid & 63, wid = tid >> 6, r = lane & 31, h = lane >> 5;
  const int wn = wid & 1, wt = wid >> 1;
  f32x16 ms[2][TJ];
#pragma unroll
  for (int i = 0; i < 2; ++i)
#pragma unroll
    for (int j = 0; j < TJ; ++j) ms[i][j] = fzero();
#pragma unroll 1
  for (int br = 0; br < 4; ++br) {
    const int zc = br == 0 ? C_AZ : br == 1 ? C_BZ : br == 2 ? C_CZ : C_DZ;
    f32x16 ag[2][TJ];
#pragma unroll
    for (int i = 0; i < 2; ++i)
#pragma unroll
      for (int j = 0; j < TJ; ++j) ag[i][j] = fzero();
    gemm_core<TJ>(Wm + ((size_t)br * 1024 + nt * 128) * 1024, 1024, H + t0 * 1024, 1024, 1024, ag, lds);
    unsigned* sgl = (unsigned*)(lds + 32768) + tid;
#pragma unroll
    for (int i = 0; i < 2; ++i)
#pragma unroll
      for (int j = 0; j < TJ; ++j)
#pragma unroll
        for (int e = 0; e < 8; ++e) sgl[((i * TJ + j) * 8 + e) * 256] = cvtpk(sigmoidf_(ag[i][j][2 * e]), sigmoidf_(ag[i][j][2 * e + 1]));
#pragma unroll
    for (int i = 0; i < 2; ++i)
#pragma unroll
      for (int j = 0; j < TJ; ++j) ag[i][j] = fzero();
    gemm_core<TJ>(Wu + ((size_t)br * 1024 + nt * 128) * 512, 512, P + t0 * PW + zc, PW, 512, ag, lds);
#pragma unroll
    for (int i = 0; i < 2; ++i)
#pragma unroll
      for (int j = 0; j < TJ; ++j)
#pragma unroll
        for (int e = 0; e < 8; ++e) { const unsigned sv = sgl[((i * TJ + j) * 8 + e) * 256]; ms[i][j][2 * e] += bflo(sv) * ag[i][j][2 * e]; ms[i][j][2 * e + 1] += bfhi(sv) * ag[i][j][2 * e + 1]; }
  }
#pragma unroll
  for (int i = 0; i < 2; ++i)
#pragma unroll
    for (int j = 0; j < TJ; ++j) {
      const size_t tok = t0 + wt * (32 * TJ) + 32 * j + r;
#pragma unroll
      for (int k2 = 0; k2 < 2; ++k2)
        store8pair(P + tok * PW + nt * 128 + wn * 64 + 32 * i + 16 * k2, h, ms[i][j][8 * k2], ms[i][j][8 * k2 + 1], ms[i][j][8 * k2 + 2], ms[i][j][8 * k2 + 3],
                   ms[i][j][8 * k2 + 4], ms[i][j][8 * k2 + 5], ms[i][j][8 * k2 + 6], ms[i][j][8 * k2 + 7]);
    }
}
DI void phase_merge(const Params& p, int layer, char* lds) {
  const int ntile = layer == 0 ? 2304 : 2048;
  (void)ntile;
  const int b = blockIdx.x & 7, li = blockIdx.x >> 3, nloc = gridDim.x >> 3;
  const int nq = layer == 0 ? 288 : 256;
  for (int q = li; q < nq; q += nloc) {
    if (q < 256) merge_tile<2>(p, (size_t)b * SU + LC + (size_t)(q >> 3) * 128, q & 7, lds);
    else merge_tile<1>(p, (size_t)b * SU + (size_t)((q - 256) >> 3) * 64, q & 7, lds);
  }
}

template <int TJ>
DI void out_tile(const Params& p, int layer, size_t t0, int nt, char* lds) {
  const u16* Wo = (const u16*)(p.ws + OFF_WO); u16* P = (u16*)(p.ws + OFF_P);
  const float* mod = (const float*)(p.ws + OFF_SMALL + SM_MOD) + (size_t)layer * 9 * 3072;
  const int tid = otid(), lane = tid & 63, wid = tid >> 6, h = lane >> 5;
  const int wn = wid & 1;
  f32x16 acc[2][TJ];
#pragma unroll
  for (int i = 0; i < 2; ++i)
#pragma unroll
    for (int j = 0; j < TJ; ++j) acc[i][j] = fzero();
  gemm_core<TJ>(Wo + (size_t)nt * 128 * 1024, 1024, P + t0 * PW, PW, 1024, acc, lds);
  const int b = (int)(t0 / SU), s0 = (int)(t0 % SU);
  const float* gt = mod + (s0 >= LC ? b : 8) * 3072 + 2048 + nt * 128 + wn * 64;
#pragma unroll
  for (int j = 0; j < TJ; ++j) {
    const int t2_ = otid();
    const size_t tok = t0 + (t2_ >> 7) * (32 * TJ) + 32 * j + (t2_ & 31);
#pragma unroll
    for (int i = 0; i < 2; ++i)
#pragma unroll
      for (int k2 = 0; k2 < 2; ++k2) {
        const float4 gx = *(const float4*)(gt + 32 * i + 16 * k2 + 4 * h), gy = *(const float4*)(gt + 32 * i + 16 * k2 + 8 + 4 * h);
        store8pair(P + tok * PW + 1024 + nt * 128 + wn * 64 + 32 * i + 16 * k2, h,
                   gx.x * acc[i][j][8 * k2], gx.y * acc[i][j][8 * k2 + 1], gx.z * acc[i][j][8 * k2 + 2], gx.w * acc[i][j][8 * k2 + 3],
                   gy.x * acc[i][j][8 * k2 + 4], gy.y * acc[i][j][8 * k2 + 5], gy.z * acc[i][j][8 * k2 + 6], gy.w * acc[i][j][8 * k2 + 7]);
      }
  }
}
DI void phase_out(const Params& p, int layer, char* lds) {
  const int ntile = layer == 0 ? 1280 : 1024;
  (void)ntile;
  const int b = blockIdx.x & 7, li = blockIdx.x >> 3, nloc = gridDim.x >> 3;
  const int nq = layer == 0 ? 160 : 128;
  for (int q = li; q < nq; q += nloc) {
    if (q < 128) out_tile<4>(p, layer, (size_t)b * SU + LC + (size_t)(q >> 3) * 256, q & 7, lds);
    else out_tile<1>(p, layer, (size_t)b * SU + (size_t)((q - 128) >> 3) * 64, q & 7, lds);
  }
}

#define XB_TMO      128
#define XB_XCNT(j)  (256  + 64 * (j))
#define XB_XSUB(j)  (1280 + 64 * (j))
#define XB_XGEN(j)  (2304 + 64 * (j))
#define XB_TOP      3328
#define XB_TOPGEN   3392
#define XCD_BAR_WORDS 3456
#define XB_SPIN_CAP (1u << 18)
#define LAS __attribute__((address_space(3)))

__device__ __forceinline__ unsigned xb_ld(unsigned* p)              { return __hip_atomic_load(p, __ATOMIC_RELAXED, __HIP_MEMORY_SCOPE_AGENT); }
__device__ __forceinline__ unsigned xb_add(unsigned* p, unsigned v) { return __hip_atomic_fetch_add(p, v, __ATOMIC_RELAXED, __HIP_MEMORY_SCOPE_AGENT); }
__device__ __forceinline__ unsigned xb_xcc_id() { return (unsigned)__builtin_amdgcn_s_getreg((3 << 11) | 20) & 0xFu; }
#define XB_SPIN(cond, bar) do { unsigned _sp = 0; while (cond) { __builtin_amdgcn_s_sleep(1); \
    if ((++_sp & 255u) == 0u) { if (xb_ld(&(bar)[XB_TMO])) break; if (_sp > XB_SPIN_CAP) { atomicAdd(&(bar)[XB_TMO], 1u); break; } } } } while (0)

struct XcdBarrier {
    unsigned* bar; unsigned x;
    volatile LAS unsigned* st;
};

__device__ __forceinline__ XcdBarrier xcd_barrier_post(unsigned* bar, volatile LAS unsigned* st) {
    XcdBarrier b; b.bar = bar; b.x = xb_xcc_id(); b.st = st;
    if (threadIdx.x == 0) (void)xb_add(&bar[XB_XCNT(b.x)], 1u);
    return b;
}
__device__ __forceinline__ void xcd_barrier_complete(unsigned* bar, unsigned x, unsigned& nloc, unsigned& nx) {
    const unsigned G = gridDim.x * gridDim.y * gridDim.z;
    unsigned sum, cnt, mine, sp = 0u;
    for (;;) {
        sum = 0u; cnt = 0u; mine = 0u;
#pragma unroll
        for (unsigned j = 0; j < 16; ++j) { const unsigned c = xb_ld(&bar[XB_XCNT(j)]); sum += c; cnt += (c > 0u) ? 1u : 0u; mine = (j == x) ? c : mine; }
        if (sum == G) break;
        __builtin_amdgcn_s_sleep(1);
        if ((++sp & 255u) == 0u) { if (xb_ld(&bar[XB_TMO])) break; if (sp > XB_SPIN_CAP) { atomicAdd(&bar[XB_TMO], 1u); break; } }
    }
    nloc = mine > 0u ? mine : 1u; nx = cnt > 0u ? cnt : 1u;
}

__device__ __forceinline__ void xcd_barrier(const XcdBarrier& b) {
    asm volatile("s_waitcnt vmcnt(0)" ::: "memory");
    __syncthreads();
    if (threadIdx.x == 0) {
        unsigned* bar = b.bar;
        __builtin_amdgcn_s_waitcnt(0);
        unsigned nloc = b.st[0], nx = b.st[1];
        if (nloc == 0u) { xcd_barrier_complete(bar, b.x, nloc, nx); b.st[0] = nloc; b.st[1] = nx; }
        const unsigned old = xb_add(&bar[XB_XSUB(b.x)], 1u);
        const unsigned gen = old / nloc;
        if (old + 1u == (gen + 1u) * nloc) {
            __builtin_amdgcn_fence(__ATOMIC_RELEASE, "agent");
            asm volatile("s_waitcnt vmcnt(0)" ::: "memory");
            const unsigned og = xb_add(&bar[XB_TOP], 1u);
            const unsigned tg = og / nx;
            if (og + 1u == (tg + 1u) * nx) xb_add(&bar[XB_TOPGEN], 1u);
            else XB_SPIN(xb_ld(&bar[XB_TOPGEN]) == tg, bar);
            __builtin_amdgcn_fence(__ATOMIC_ACQUIRE, "agent");
            xb_add(&bar[XB_XGEN(b.x)], 1u);
            asm volatile("s_waitcnt vmcnt(0)" ::: "memory");
        } else {
            XB_SPIN(xb_ld(&bar[XB_XGEN(b.x)]) == gen, bar);
            __builtin_amdgcn_fence(__ATOMIC_ACQUIRE, "agent");
            asm volatile("s_waitcnt vmcnt(0)" ::: "memory");
        }
    }
    __syncthreads();
}

__global__ void __launch_bounds__(256, 2) mega(Params p, int ph_lo, int ph_hi) {
  __shared__ __attribute__((aligned(16))) char lds[65536 + 16];
  volatile LAS unsigned* xst = (volatile LAS unsigned*)(lds + 65544);
  if (threadIdx.x == 0) { xst[0] = 0u; xst[1] = 0u; }
  __syncthreads();
  const XcdBarrier xb = xcd_barrier_post((unsigned*)(p.ws + OFF_SMALL + SM_BAR), xst);
  if (ph_hi == 12345) cg::this_grid().sync();
  for (int ph = ph_lo; ph < ph_hi; ++ph) {
    if (ph == 0) {
      for (int item = blockIdx.x; item < 193 + 3296; item += gridDim.x) {
        if (!(PHM & 1)) continue;
        if (item == 0) misc_item(p);
        else if (item < 193) adaln_item(p, item - 1, lds);
        else weights_item(p, 0, item - 193, lds);
      }
    } else if (ph == 13) {
      if (PHM & 1) final_ln(p);
    } else {
      const int layer = (ph - 1) / 6, sp = (ph - 1) % 6;
      if (sp == 0) {
        if (PHM & 1) ln_rows(p, layer);
        if ((PHM & 1) && layer == 1) for (int item = blockIdx.x; item < 3296; item += gridDim.x) weights_item(p, 1, item, lds);
      } else if (sp == 1) { if (PHM & 2) phase_inproj(p, layer, lds); if (DUPC) { cg::this_grid().sync(); phase_inproj(p, layer, lds); } }
      else if (sp == 2) { if (PHM & 4) phase_mix(p, layer, 0, lds); }
      else if (sp == 3) { if (PHM & 4) phase_mix(p, layer, 1, lds); }
      else if (sp == 4) { if (PHM & 8) phase_merge(p, layer, lds); if (DUPE) { cg::this_grid().sync(); phase_merge(p, layer, lds); } }
      else { if (PHM & 16) phase_out(p, layer, lds); }
    }
    if (ph + 1 < ph_hi) xcd_barrier(xb);
  }
}

extern "C" void kernel_launch(void* const* d_in, const int* in_sizes, int n_in, void* d_out, int out_size, void* d_ws, size_t ws_size,
                              hipStream_t stream) {
  Params p{};
  p.x = (const float*)d_in[0]; p.c = (const float*)d_in[1]; p.ctx = (const float*)d_in[2]; p.c_ctx = (const float*)d_in[3];
  p.w_ada = (const float*)d_in[4]; p.b_ada = (const float*)d_in[5]; p.w_in = (const float*)d_in[6]; p.gla_w_gate = (const float*)d_in[7];
  p.gla_b_gate = (const float*)d_in[8]; p.gla_norm = (const float*)d_in[9]; p.win_sink = (const float*)d_in[10];
  p.glb_q_norm = (const float*)d_in[11]; p.glb_k_norm = (const float*)d_in[12]; p.diff_lambda = (const float*)d_in[13];
  p.diff_norm = (const float*)d_in[14]; p.w_merge = (const float*)d_in[15]; p.w_up = (const float*)d_in[16]; p.w_out = (const float*)d_in[17];
  p.ln_g = (const float*)d_in[18]; p.ln_b = (const float*)d_in[19];
  p.out = (float*)d_out; p.ws = (char*)d_ws;
  if (ws_size < WS_NEED) { fprintf(stderr, "workspace too small: %zu < %zu\n", ws_size, (size_t)WS_NEED); return; }
  static int grid_blocks = 0;
  if (!grid_blocks) {
    int dev = 0, cus = 0, per_cu = 0;
    hipGetDevice(&dev);
    hipDeviceGetAttribute(&cus, hipDeviceAttributeMultiprocessorCount, dev);
    hipOccupancyMaxActiveBlocksPerMultiprocessor(&per_cu, mega, 256, 0);
    if (per_cu > 2) per_cu = 2;
    if (per_cu < 1) per_cu = 1;
    grid_blocks = cus * per_cu;
  }
  hipMemsetAsync((char*)d_ws + OFF_SMALL + SM_BAR, 0, XCD_BAR_WORDS * sizeof(unsigned), stream);
  int lo = 0, hi = 14;
  void* args[] = {&p, &lo, &hi};
  hipError_t e = hipLaunchCooperativeKernel((void*)mega, dim3(grid_blocks), dim3(256), args, 0, stream);
  if (e != hipSuccess) fprintf(stderr, "cooperative launch failed: %s (grid %d)\n", hipGetErrorString(e), grid_blocks);
}
```

```cpp
#include <hip/hip_runtime.h>
#include <hip/hip_cooperative_groups.h>
#include <cstdio>
#include <cstdint>
namespace cg = cooperative_groups;

typedef unsigned short u16;
using bf16x8 = __attribute__((ext_vector_type(8))) short;
using s16x4 = __attribute__((ext_vector_type(4))) short;
using f32x16 = __attribute__((ext_vector_type(16))) float;
using u32x4 = __attribute__((ext_vector_type(4))) unsigned;
using u32x2 = __attribute__((ext_vector_type(2))) unsigned;
typedef short v4i16_t __attribute__((ext_vector_type(4)));
typedef __attribute__((address_space(3))) const char* lds_cptr;
#define DI __device__ __forceinline__
#define MFMA(a, b, c) __builtin_amdgcn_mfma_f32_32x32x16_bf16((a), (b), (c), 0, 0, 0)

#ifndef COOP
#define COOP 1
#endif
#ifndef DUPC
#define DUPC 0
#endif
#ifndef DUPE
#define DUPE 0
#endif
#ifndef GLAREP
#define GLAREP 0
#endif
#ifndef PHM
#define PHM 0xff
#endif

constexpr int NB = 8, SEQ = 4096, LC = 256, SU = 4352, T = NB * SU, DM = 1024, PW = 5920;
constexpr float EPS = 1e-6f;
constexpr float LOG2E = 1.4426950408889634f;
constexpr float QS = 0.125f * LOG2E;
constexpr float ALPHA = 1.4142135623730951f;
constexpr int C_AQ = 0, C_AK = 256, C_AV = 512, C_AZ = 1024, C_BQ = 1536, C_BK = 2048, C_BV = 2176, C_BZ = 2304,
              C_CQ = 2816, C_CK = 3328, C_CV = 3584, C_CZ = 3840, C_DQ = 4352, C_DK = 4864, C_DV = 5120, C_DZ = 5376, C_AG = 5888;
constexpr int NWIN = 6016;
constexpr size_t OFF_P = 0;
constexpr size_t OFF_H = OFF_P + (size_t)T * PW * 2;
constexpr size_t OFF_WM = OFF_H + (size_t)T * DM * 2;
constexpr size_t OFF_WU = OFF_WM + (size_t)4 * 1024 * 1024 * 2;
constexpr size_t OFF_WO = OFF_WU + (size_t)4 * 1024 * 512 * 2;
constexpr size_t OFF_SMALL = OFF_WO + (size_t)1024 * 1024 * 2;
constexpr size_t OFF_WIN = OFF_SMALL + (1u << 20);
constexpr size_t OFF_XC1 = OFF_WIN + (size_t)NWIN * 1024 * 2;
constexpr size_t OFF_GTMP = OFF_WIN;
constexpr size_t OFF_DEC = OFF_GTMP + (size_t)T * 512 * 2;
constexpr size_t WS_NEED = OFF_DEC + (size_t)64 * 68 * 64 * 4;
constexpr size_t SM_MOD = 0;
constexpr size_t SM_TAB = 256 * 1024;
constexpr size_t SM_LAM = SM_TAB + 16 * 1024;
constexpr size_t SM_BAR = 512 * 1024;
constexpr size_t SM_CTR = SM_LAM + 256;

struct Params {
  const float *x, *c, *ctx, *c_ctx, *w_ada, *b_ada, *w_in, *gla_w_gate, *gla_b_gate, *gla_norm, *win_sink,
      *glb_q_norm, *glb_k_norm, *diff_lambda, *diff_norm, *w_merge, *w_up, *w_out, *ln_g, *ln_b;
  float* out;
  char* ws;
};

DI int otid() { int t = threadIdx.x; asm volatile("" : "+v"(t)); return t; }
DI int crow(int reg, int h) { return (reg & 3) + 8 * (reg >> 2) + 4 * h; }
typedef float f32x2_t __attribute__((ext_vector_type(2)));
typedef __bf16 bf16x2_t __attribute__((ext_vector_type(2)));
DI unsigned cvtpk(float lo, float hi) { f32x2_t v = {lo, hi}; bf16x2_t b = __builtin_convertvector(v, bf16x2_t); return __builtin_bit_cast(unsigned, b); }
DI u16 f2bf(float x) { return (u16)(cvtpk(x, 0.f) & 0xffffu); }
DI float bf2f(u16 v) { return __uint_as_float((unsigned)v << 16); }
DI float bflo(unsigned u) { return __uint_as_float(u << 16); }
DI float bfhi(unsigned u) { return __uint_as_float(u & 0xffff0000u); }
DI bf16x8 pack8(const f32x16& x, int s) {
  u32x4 p;
  p[0] = cvtpk(x[8 * s + 0], x[8 * s + 1]); p[1] = cvtpk(x[8 * s + 2], x[8 * s + 3]);
  p[2] = cvtpk(x[8 * s + 4], x[8 * s + 5]); p[3] = cvtpk(x[8 * s + 6], x[8 * s + 7]);
  return __builtin_bit_cast(bf16x8, p);
}
DI s16x4 vtr(const char* p) { return __builtin_bit_cast(s16x4, __builtin_amdgcn_ds_read_tr16_b64_v4i16((__attribute__((address_space(3))) v4i16_t*)(lds_cptr)p)); }
DI bf16x8 cat8(s16x4 lo, s16x4 hi) { return __builtin_shufflevector(lo, hi, 0, 1, 2, 3, 4, 5, 6, 7); }
DI float fexp2(float x) { return __builtin_amdgcn_exp2f(x); }
DI float sigmoidf_(float x) { return __builtin_amdgcn_rcpf(1.f + __expf(-x)); }
DI float siluf_(float x) { return x * __builtin_amdgcn_rcpf(1.f + __expf(-x)); }
DI float hsum(float v) { auto rr = __builtin_amdgcn_permlane32_swap(__float_as_uint(v), __float_as_uint(v), false, false); return __uint_as_float(rr[0]) + __uint_as_float(rr[1]); }
DI float mx2(float a, float b) { return __builtin_elementwise_maximum(a, b); }
DI float hmax(float v) { auto rr = __builtin_amdgcn_permlane32_swap(__float_as_uint(v), __float_as_uint(v), false, false); return mx2(__uint_as_float(rr[0]), __uint_as_float(rr[1])); }
DI float shx(float v, int o, int lane) { return __int_as_float(__builtin_amdgcn_ds_bpermute((lane ^ o) << 2, __float_as_int(v))); }
DI float wsum(float v, int lane) {
#pragma unroll
  for (int o = 1; o < 32; o <<= 1) v += shx(v, o, lane);
  return hsum(v);
}
DI f32x16 fzero() { f32x16 z; for (int i = 0; i < 16; ++i) z[i] = 0.f; return z; }
DI void store8pair(u16* base, int h, float a0, float a1, float a2, float a3, float b0, float b1, float b2, float b3) {
  const unsigned x0 = cvtpk(a0, a1), x1 = cvtpk(a2, a3), y0 = cvtpk(b0, b1), y1 = cvtpk(b2, b3);
  auto r0 = __builtin_amdgcn_permlane32_swap(x0, y0, false, false);
  auto r1 = __builtin_amdgcn_permlane32_swap(x1, y1, false, false);
  u32x4 v; v[0] = r0[0]; v[1] = r1[0]; v[2] = r0[1]; v[3] = r1[1];
  *(u32x4*)(base + 8 * h) = v;
}
DI void load8pair(const u16* base, int h, u32x2& x, u32x2& y) {
  const u32x4 v = *(const u32x4*)(base + 8 * h);
  auto r0 = __builtin_amdgcn_permlane32_swap(v[0], v[2], false, false);
  auto r1 = __builtin_amdgcn_permlane32_swap(v[1], v[3], false, false);
  x[0] = r0[0]; x[1] = r1[0]; y[0] = r0[1]; y[1] = r1[1];
}
DI void store4bf(u16* dst, float a, float b, float c, float d) { u32x2 v; v[0] = cvtpk(a, b); v[1] = cvtpk(c, d); *(u32x2*)dst = v; }

template <int TJ>
DI void gemm_core(const u16* __restrict__ W, int ldw, const u16* __restrict__ X, int ldx, int K, f32x16 (&acc)[2][TJ], char* lds) {
  constexpr int XR = 64 * TJ;
  constexpr int WBYTES = 128 * 64, XBYTES = XR * 64, STAGE = WBYTES + XBYTES;
  const int tid = otid(), lane = tid & 63, wid = tid >> 6, r = lane & 31, h = lane >> 5;
  const int wn = wid & 1, wt = wid >> 1;
  u32x4 wA[2], xA[TJ], wB[2], xB[TJ];
  const int lrow = tid >> 2, lch = tid & 3;
  const u16* wp = W + (size_t)lrow * ldw + lch * 8;
  const u16* xp = X + (size_t)lrow * ldx + lch * 8;
  const int nk = K / 32;
#define G_LOAD(wr, xr, kt_)                                                                                     \
  {                                                                                                             \
    _Pragma("unroll") for (int it = 0; it < 2; ++it) wr[it] = *(const u32x4*)(wp + (size_t)(64 * it) * ldw + (kt_) * 32);  \
    _Pragma("unroll") for (int it = 0; it < TJ; ++it) xr[it] = *(const u32x4*)(xp + (size_t)(64 * it) * ldx + (kt_) * 32); \
  }
#define G_STORE(wr, xr, buf_)                                                                                   \
  {                                                                                                             \
    char* nb_ = lds + (buf_) * STAGE;                                                                           \
    _Pragma("unroll") for (int it = 0; it < 2; ++it) { int row = lrow + 64 * it; *(u32x4*)(nb_ + lch * (128 * 16) + ((row ^ (2 * lch)) * 16)) = wr[it]; }          \
    _Pragma("unroll") for (int it = 0; it < TJ; ++it) { int row = lrow + 64 * it; *(u32x4*)(nb_ + WBYTES + lch * (XR * 16) + ((row ^ (2 * lch)) * 16)) = xr[it]; } \
  }
#define G_COMPUTE(buf_)                                                                                         \
  {                                                                                                             \
    const char* base = lds + (buf_) * STAGE;                                                                    \
    _Pragma("unroll") for (int s = 0; s < 2; ++s) {                                                             \
      const int ch = 2 * s + h;                                                                                 \
      bf16x8 wf[2], xf[TJ];                                                                                     \
      _Pragma("unroll") for (int i = 0; i < 2; ++i) { int row = wn * 64 + 32 * i + r; wf[i] = *(const bf16x8*)(base + ch * 2048 + ((row ^ (2 * ch)) * 16)); } \
      _Pragma("unroll") for (int j = 0; j < TJ; ++j) { int row = wt * (32 * TJ) + 32 * j + r; xf[j] = *(const bf16x8*)(base + WBYTES + ch * (XR * 16) + ((row ^ (2 * ch)) * 16)); } \
      __builtin_amdgcn_s_setprio(1);                                                                            \
      _Pragma("unroll") for (int i = 0; i < 2; ++i)                                                             \
        _Pragma("unroll") for (int j = 0; j < TJ; ++j) acc[i][j] = MFMA(wf[i], xf[j], acc[i][j]);              \
      __builtin_amdgcn_s_setprio(0);                                                                            \
    }                                                                                                           \
  }
  G_LOAD(wA, xA, 0);
  G_LOAD(wB, xB, 1);
  G_STORE(wA, xA, 0);
  __syncthreads();
  for (int kt = 0; kt < nk; kt += 2) {
    if (kt + 2 < nk) G_LOAD(wA, xA, kt + 2);
    G_COMPUTE(0);
    G_STORE(wB, xB, 1);
    __syncthreads();
    if (kt + 3 < nk) G_LOAD(wB, xB, kt + 3);
    G_COMPUTE(1);
    if (kt + 2 < nk) G_STORE(wA, xA, 0);
    __syncthreads();
  }
#undef G_LOAD
#undef G_STORE
#undef G_COMPUTE
}

DI void tconv_tile(const float* __restrict__ src, int ns, int K, int k0, int n0, int srccol0, int nvalid, u16* __restrict__ dst, char* lds) {
  float* tl = (float*)lds;
  const int tid = otid();
  const int j4 = (tid & 15) * 4, i0 = tid >> 4;
#pragma unroll
  for (int it = 0; it < 4; ++it) {
    int i = i0 + 16 * it;
    float4 v = make_float4(0.f, 0.f, 0.f, 0.f);
    if (srccol0 >= 0 && j4 < nvalid) v = *(const float4*)(src + (size_t)(k0 + i) * ns + srccol0 + j4);
    tl[i * 65 + j4 + 0] = v.x; tl[i * 65 + j4 + 1] = v.y; tl[i * 65 + j4 + 2] = v.z; tl[i * 65 + j4 + 3] = v.w;
  }
  __syncthreads();
  const int n = tid >> 2, kq = (tid & 3) * 16;
  u32x4 o0, o1;
#pragma unroll
  for (int e = 0; e < 4; ++e) {
    o0[e] = cvtpk(tl[(kq + 2 * e) * 65 + n], tl[(kq + 2 * e + 1) * 65 + n]);
    o1[e] = cvtpk(tl[(kq + 8 + 2 * e) * 65 + n], tl[(kq + 8 + 2 * e + 1) * 65 + n]);
  }
  u16* d = dst + (size_t)(n0 + n) * K + k0 + kq;
  *(u32x4*)d = o0; *(u32x4*)(d + 8) = o1;
  __syncthreads();
}

DI void weights_item(const Params& p, int layer, int item, char* lds) {
  if (item < 1504) {
    int nt = item >> 4, kt = item & 15;
    int n0 = nt * 64, sc, nv = 64;
    if (n0 < 1024) sc = n0; else if (n0 < 5888) sc = n0 + 32; else if (n0 == 5888) { sc = 1024; nv = 32; } else sc = -1;
    tconv_tile(p.w_in + (size_t)layer * 1024 * 5920, 5920, 1024, kt * 64, n0, sc, nv, (u16*)(p.ws + OFF_WIN), lds);
  } else if (item < 2528) {
    int id = item - 1504; int br = id >> 8, nt = (id >> 4) & 15, kt = id & 15;
    tconv_tile(p.w_merge + ((size_t)layer * 4 + br) * 1024 * 1024, 1024, 1024, kt * 64, nt * 64, nt * 64, 64, (u16*)(p.ws + OFF_WM) + (size_t)br * 1024 * 1024, lds);
  } else if (item < 3040) {
    int id = item - 2528; int br = id >> 7, nt = (id >> 3) & 15, kt = id & 7;
    tconv_tile(p.w_up + ((size_t)layer * 4 + br) * 512 * 1024, 1024, 512, kt * 64, nt * 64, nt * 64, 64, (u16*)(p.ws + OFF_WU) + (size_t)br * 1024 * 512, lds);
  } else {
    int id = item - 3040; int nt = id >> 4, kt = id & 15;
    tconv_tile(p.w_out + (size_t)layer * 1024 * 1024, 1024, 1024, kt * 64, nt * 64, nt * 64, 64, (u16*)(p.ws + OFF_WO), lds);
  }
}

DI void adaln_item(const Params& p, int item, char* lds) {
  const int layer = item / 96, j0 = (item % 96) * 32;
  float* sl = (float*)lds;
  const int tid = otid();
  for (int e = tid; e < 9 * 1024; e += 256) { int rr = e >> 10, k = e & 1023; float v = rr < 8 ? p.c[rr * 1024 + k] : p.c_ctx[k]; sl[e] = siluf_(v); }
  __syncthreads();
  const int c4 = tid & 7, ks = tid >> 3;
  float a[9][4];
#pragma unroll
  for (int rr = 0; rr < 9; ++rr) { a[rr][0] = 0.f; a[rr][1] = 0.f; a[rr][2] = 0.f; a[rr][3] = 0.f; }
  const float* wp = p.w_ada + (size_t)layer * 1024 * 3072 + j0 + c4 * 4;
#pragma unroll 8
  for (int k = ks * 32; k < ks * 32 + 32; ++k) {
    const float4 w = *(const float4*)(wp + (size_t)k * 3072);
#pragma unroll
    for (int rr = 0; rr < 9; ++rr) {
      const float sv = sl[rr * 1024 + k];
      a[rr][0] += sv * w.x; a[rr][1] += sv * w.y; a[rr][2] += sv * w.z; a[rr][3] += sv * w.w;
    }
  }
  __syncthreads();
  float* red = sl;
#pragma unroll
  for (int rr = 0; rr < 9; ++rr) *(float4*)(red + (ks * 9 + rr) * 32 + c4 * 4) = make_float4(a[rr][0], a[rr][1], a[rr][2], a[rr][3]);
  __syncthreads();
  float* mod = (float*)(p.ws + OFF_SMALL + SM_MOD);
  for (int e = tid; e < 9 * 32; e += 256) {
    int rr = e >> 5, cc = e & 31; float sacc = p.b_ada[layer * 3072 + j0 + cc];
#pragma unroll 8
    for (int q = 0; q < 32; ++q) sacc += red[(q * 9 + rr) * 32 + cc];
    mod[((size_t)layer * 9 + rr) * 3072 + j0 + cc] = sacc;
  }
  __syncthreads();
}

DI void misc_item(const Params& p) {
  const int tid = otid();
  float2* tab = (float2*)(p.ws + OFF_SMALL + SM_TAB);
  for (int e = tid; e < 1024; e += 256) {
    int pos = e >> 4, f = e & 15;
    float freq = powf(10000.0f, -(float)f / 16.0f);
    float ang = (float)pos * freq;
    tab[e] = make_float2(cosf(ang), sinf(ang));
  }
  if (tid < 96) ((int*)(p.ws + OFF_SMALL + SM_CTR))[tid] = 0;
  if (tid < 2) {
    const float* lp = p.diff_lambda + tid * 256;
    float s1 = 0.f, s2 = 0.f;
    for (int d = 0; d < 64; ++d) { s1 += lp[d] * lp[64 + d]; s2 += lp[128 + d] * lp[192 + d]; }
    float li = tid == 0 ? 0.2f : 0.35550906759096927f;
    ((float*)(p.ws + OFF_SMALL + SM_LAM))[tid] = expf(s1) - expf(s2) + li;
  }
}

DI void ln_rows(const Params& p, int layer) {
  const int tid = otid(), lane = tid & 63, wid = tid >> 6;
  const float* mod = (const float*)(p.ws + OFF_SMALL + SM_MOD) + (size_t)layer * 9 * 3072;
  u16* H = (u16*)(p.ws + OFF_H);
  float* xc1 = (float*)(p.ws + OFF_XC1);
  for (int row = blockIdx.x * 4 + wid; row < T; row += gridDim.x * 4) {
    const int b = row / SU, s = row % SU;
    const float* src; float* dst;
    const float* md;
    if (s < LC) { const size_t off = ((size_t)b * LC + s) * DM; src = p.ctx + off; dst = xc1 + off; md = mod + 8 * 3072; }
    else { const size_t off = ((size_t)b * SEQ + s - LC) * DM; src = p.x + off; dst = p.out + off; md = mod + b * 3072; }
    float4 v[4];
#pragma unroll
    for (int i = 0; i < 4; ++i) v[i] = *(const float4*)(src + i * 256 + lane * 4);
    if (layer == 1) {
      const u16* up = (const u16*)(p.ws + OFF_P) + (size_t)row * PW + 1024;
#pragma unroll
      for (int i = 0; i < 4; ++i) {
        const u32x2 uu = *(const u32x2*)(up + i * 256 + lane * 4);
        v[i].x = ALPHA * v[i].x + bflo(uu[0]); v[i].y = ALPHA * v[i].y + bfhi(uu[0]);
        v[i].z = ALPHA * v[i].z + bflo(uu[1]); v[i].w = ALPHA * v[i].w + bfhi(uu[1]);
      }
      float sm = 0.f;
#pragma unroll
      for (int i = 0; i < 4; ++i) sm += v[i].x + v[i].y + v[i].z + v[i].w;
      sm = wsum(sm, lane);
      const float mu = sm * (1.f / 1024.f);
      float sq = 0.f;
#pragma unroll
      for (int i = 0; i < 4; ++i) { float a = v[i].x - mu, bq = v[i].y - mu, cq = v[i].z - mu, d = v[i].w - mu; sq += a * a + bq * bq + cq * cq + d * d; }
      sq = wsum(sq, lane);
      const float rstd = rsqrtf(sq * (1.f / 1024.f) + EPS);
#pragma unroll
      for (int i = 0; i < 4; ++i) {
        float4 g = *(const float4*)(p.ln_g + i * 256 + lane * 4), be = *(const float4*)(p.ln_b + i * 256 + lane * 4);
        v[i].x = (v[i].x - mu) * rstd * g.x + be.x; v[i].y = (v[i].y - mu) * rstd * g.y + be.y;
        v[i].z = (v[i].z - mu) * rstd * g.z + be.z; v[i].w = (v[i].w - mu) * rstd * g.w + be.w;
        *(float4*)(dst + i * 256 + lane * 4) = v[i];
      }
    }
    float sm = 0.f;
#pragma unroll
    for (int i = 0; i < 4; ++i) sm += v[i].x + v[i].y + v[i].z + v[i].w;
    sm = wsum(sm, lane);
    const float mu = sm * (1.f / 1024.f);
    float sq = 0.f;
#pragma unroll
    for (int i = 0; i < 4; ++i) { float a = v[i].x - mu, bq = v[i].y - mu, cq = v[i].z - mu, d = v[i].w - mu; sq += a * a + bq * bq + cq * cq + d * d; }
    sq = wsum(sq, lane);
    const float rstd = rsqrtf(sq * (1.f / 1024.f) + EPS);
#pragma unroll
    for (int i = 0; i < 4; ++i) {
      const int cidx = i * 256 + lane * 4;
      float4 sh = *(const float4*)(md + cidx), sc = *(const float4*)(md + 1024 + cidx);
      float a = (v[i].x - mu) * rstd * (1.f + sc.x) + sh.x, bq = (v[i].y - mu) * rstd * (1.f + sc.y) + sh.y;
      float cq = (v[i].z - mu) * rstd * (1.f + sc.z) + sh.z, d = (v[i].w - mu) * rstd * (1.f + sc.w) + sh.w;
      store4bf(H + (size_t)row * DM + cidx, a, bq, cq, d);
    }
  }
}

DI void final_ln(const Params& p) {
  const int tid = otid(), lane = tid & 63, wid = tid >> 6;
  const float* g_ = p.ln_g + 1024; const float* b_ = p.ln_b + 1024;
  for (int row = blockIdx.x * 4 + wid; row < NB * SEQ; row += gridDim.x * 4) {
    float* src = p.out + (size_t)row * DM;
    const u16* up = (const u16*)(p.ws + OFF_P) + ((size_t)(row >> 12) * SU + LC + (row & 4095)) * PW + 1024;
    float4 v[4];
#pragma unroll
    for (int i = 0; i < 4; ++i) {
      v[i] = *(const float4*)(src + i * 256 + lane * 4);
      const u32x2 uu = *(const u32x2*)(up + i * 256 + lane * 4);
      v[i].x = ALPHA * v[i].x + bflo(uu[0]); v[i].y = ALPHA * v[i].y + bfhi(uu[0]);
      v[i].z = ALPHA * v[i].z + bflo(uu[1]); v[i].w = ALPHA * v[i].w + bfhi(uu[1]);
    }
    float sm = 0.f;
#pragma unroll
    for (int i = 0; i < 4; ++i) sm += v[i].x + v[i].y + v[i].z + v[i].w;
    sm = wsum(sm, lane);
    const float mu = sm * (1.f / 1024.f);
    float sq = 0.f;
#pragma unroll
    for (int i = 0; i < 4; ++i) { float a = v[i].x - mu, bq = v[i].y - mu, cq = v[i].z - mu, d = v[i].w - mu; sq += a * a + bq * bq + cq * cq + d * d; }
    sq = wsum(sq, lane);
    const float rstd = rsqrtf(sq * (1.f / 1024.f) + EPS);
#pragma unroll
    for (int i = 0; i < 4; ++i) {
      float4 g = *(const float4*)(g_ + i * 256 + lane * 4), be = *(const float4*)(b_ + i * 256 + lane * 4);
      v[i].x = (v[i].x - mu) * rstd * g.x + be.x; v[i].y = (v[i].y - mu) * rstd * g.y + be.y;
      v[i].z = (v[i].z - mu) * rstd * g.z + be.z; v[i].w = (v[i].w - mu) * rstd * g.w + be.w;
      *(float4*)(src + i * 256 + lane * 4) = v[i];
    }
  }
}

DI void phase_inproj(const Params& p, int layer, char* lds) {
  const u16* Wt = (const u16*)(p.ws + OFF_WIN); const u16* H = (const u16*)(p.ws + OFF_H); u16* P = (u16*)(p.ws + OFF_P);
  const float2* tab = (const float2*)(p.ws + OFF_SMALL + SM_TAB);
  const int tid = otid(), lane = tid & 63, wid = tid >> 6, r = lane & 31, h = lane >> 5;
  const int wn = wid & 1, wt = wid >> 1;
  const int xcd = blockIdx.x & 7, li = blockIdx.x >> 3, nloc = gridDim.x >> 3;
  for (int q = li; q < 6 * 17 * 8; q += nloc) {
    const int ni = q & 7, a = (q >> 3) % 17, ng = (q >> 3) / 17;
    const int tt = 8 * a + xcd, nt = ng * 8 + ni;
    if (nt >= 47) continue;
    f32x16 acc[2][4];
#pragma unroll
    for (int i = 0; i < 2; ++i)
#pragma unroll
      for (int j = 0; j < 4; ++j) acc[i][j] = fzero();
    gemm_core<4>(Wt + (size_t)nt * 128 * 1024, 1024, H + (size_t)tt * 256 * 1024, 1024, 1024, acc, lds);
    const int u = nt * 2 + wn;
    if (u >= 93) continue;
    bool rope = false; const float* gain = nullptr; float scl = 1.f;
    if (u < 4) scl = 0.125f;
    else if (u >= 24 && u < 32) { rope = true; scl = QS; }
    else if (u >= 32 && u < 34) rope = true;
    else if (u >= 44 && u < 52) { rope = true; scl = QS; gain = p.glb_q_norm + layer * 64; }
    else if (u >= 52 && u < 56) { rope = true; gain = p.glb_k_norm + layer * 64; }
    else if (u >= 68 && u < 76) { rope = true; scl = QS; }
    else if (u >= 76 && u < 80) rope = true;
    const int s0 = (tt % 17) * 256;
    const bool isx = s0 >= LC;
#pragma unroll
    for (int j = 0; j < 4; ++j) {
      const int t2_ = otid();
      const int tl = (t2_ >> 7) * 128 + 32 * j + (t2_ & 31);
      const size_t tok = (size_t)tt * 256 + tl;
      if (gain) {
        float ss = 0.f;
#pragma unroll
        for (int i = 0; i < 2; ++i)
#pragma unroll
          for (int reg = 0; reg < 16; ++reg) ss += acc[i][j][reg] * acc[i][j][reg];
        ss = hsum(ss);
        const float inv = rsqrtf(ss * (1.f / 64.f) + EPS);
#pragma unroll
        for (int i = 0; i < 2; ++i)
#pragma unroll
          for (int reg = 0; reg < 16; ++reg) acc[i][j][reg] *= inv * gain[32 * i + crow(reg, h)];
      }
      if (rope && isx) {
        const int t = s0 - LC + tl;
        const int prow = t >> 6, pcol = t & 63;
#pragma unroll
        for (int i = 0; i < 2; ++i) {
          const int pos = i == 0 ? prow : pcol;
#pragma unroll
          for (int reg = 0; reg < 8; ++reg) {
            const float2 cs = tab[pos * 16 + crow(reg, h)];
            const float x1 = acc[i][j][reg], x2 = acc[i][j][reg + 8];
            acc[i][j][reg] = x1 * cs.x - x2 * cs.y;
            acc[i][j][reg + 8] = x2 * cs.x + x1 * cs.y;
          }
        }
      }
#pragma unroll
      for (int i = 0; i < 2; ++i) {
        if (u == 92 && i == 1) continue;
#pragma unroll
        for (int k2 = 0; k2 < 2; ++k2) {
          u16* dst = P + tok * PW + u * 64 + 32 * i + 16 * k2;
          store8pair(dst, h, acc[i][j][8 * k2] * scl, acc[i][j][8 * k2 + 1] * scl, acc[i][j][8 * k2 + 2] * scl, acc[i][j][8 * k2 + 3] * scl,
                     acc[i][j][8 * k2 + 4] * scl, acc[i][j][8 * k2 + 5] * scl, acc[i][j][8 * k2 + 6] * scl, acc[i][j][8 * k2 + 7] * scl);
        }
      }
    }
  }
}

DI void stage_q(const u16* qptr, char* lds) {
  const int tid = otid(), lane = tid & 63, r = lane & 31, h = lane >> 5;
  char* qlds = lds + 49152 + (tid >> 6) * 4096;
  bf16x8 q[4];
#pragma unroll
  for (int s = 0; s < 4; ++s) q[s] = *(const bf16x8*)(qptr + 16 * s + 8 * h);
#pragma unroll
  for (int s = 0; s < 4; ++s) { const int ch = 2 * s + h; *(bf16x8*)(qlds + ch * 512 + ((r ^ ch) * 16)) = q[s]; }
}
template <int DV>
DI void attn_core(const u16* __restrict__ P, size_t tokbase, int kcol, int vcol, int n1, int n2, int xs0,
                  bool win, int tq, float m0, float l0, f32x16 (&o)[DV / 32], float& lsum, char* lds) {
  constexpr int KB = 8192, VB = 64 * DV * 2, STAGE = KB + VB;
  constexpr int NVL = DV / 32, VSH = (DV == 64 ? 3 : 4);
  constexpr float THR = 6.f;
  const int tid = otid(), lane = tid & 63, r = lane & 31, h = lane >> 5;
  const char* qlds = lds + 49152 + (tid >> 6) * 4096;
  bf16x8 qreg[4];
#pragma unroll
  for (int s = 0; s < 4; ++s) { const int ch = 2 * s + h; qreg[s] = *(const bf16x8*)(qlds + ch * 512 + ((r ^ ch) * 16)); }
  u32x4 kA[2], vA[NVL], kB[2], vB[NVL];
  const int ntiles = n1 + n2;
  const int kkey = tid >> 3, kch = tid & 7;
  const int vkey = tid >> VSH, vpc = tid & ((1 << VSH) - 1);
  const int vstep = 256 >> VSH;
  const bool autoinit = (l0 == 0.f);
  float m = autoinit ? 0.f : m0, l = (h == 0) ? l0 : 0.f;
  f32x16 negm;
#pragma unroll
  for (int reg = 0; reg < 16; ++reg) negm[reg] = -m;
#pragma unroll
  for (int b = 0; b < DV / 32; ++b) o[b] = fzero();
  const int trofs = (4 * h + ((lane & 15) >> 2)) * 64 + ((lane >> 4) & 1) * 32 + (lane & 3) * 8;
#define A_LOAD(kr, vr, t_)                                                                                          \
  {                                                                                                                 \
    const int s0_ = ((t_) < n1) ? (t_) * 64 : xs0 + ((t_) - n1) * 64;                                               \
    const u16* kb_ = P + (tokbase + s0_) * PW;                                                                      \
    _Pragma("unroll") for (int i = 0; i < 2; ++i) kr[i] = *(const u32x4*)(kb_ + (size_t)(kkey + 32 * i) * PW + kcol + kch * 8);        \
    _Pragma("unroll") for (int i = 0; i < NVL; ++i) vr[i] = *(const u32x4*)(kb_ + (size_t)(vkey + vstep * i) * PW + vcol + vpc * 8);  \
  }
#define A_STORE(kr, vr, buf_)                                                                                       \
  {                                                                                                                 \
    char* nb_ = lds + (buf_) * STAGE;                                                                               \
    _Pragma("unroll") for (int i = 0; i < 2; ++i) { int key = kkey + 32 * i; *(u32x4*)(nb_ + kch * 1024 + ((key ^ kch) * 16)) = kr[i]; }   \
    _Pragma("unroll") for (int i = 0; i < NVL; ++i) { int key = vkey + vstep * i; *(u32x4*)(nb_ + KB + (vpc >> 2) * 4096 + key * 64 + (vpc & 3) * 16) = vr[i]; } \
  }
  auto compute = [&](const char* base, int it) __attribute__((always_inline)) {
    const bool domask = win && it >= n1;
    const int kt0 = xs0 + (it - n1) * 64 - LC;
#pragma unroll
    for (int ks = 0; ks < 2; ++ks) {
      f32x16 pt = negm;
#pragma unroll
      for (int s = 0; s < 4; ++s) {
        const int ch = 2 * s + h, key = 32 * ks + r;
        const bf16x8 kf = *(const bf16x8*)(base + ch * 1024 + ((key ^ ch) * 16));
        const bf16x8 qf = qreg[s];
        pt = MFMA(kf, qf, pt);
      }
      if (domask) {
#pragma unroll
        for (int reg = 0; reg < 16; ++reg) {
          const int d = tq - (kt0 + 32 * ks + crow(reg, h));
          if (d > 128 || d < -128) pt[reg] = -1e30f;
        }
      }
      float mloc = mx2(pt[0], pt[1]);
#pragma unroll
      for (int reg = 2; reg < 16; reg += 2) mloc = mx2(mx2(mloc, pt[reg]), pt[reg + 1]);
      mloc = hmax(mloc);
      const bool first = autoinit && it == 0 && ks == 0;
      if (first || __builtin_amdgcn_ballot_w64(mloc > THR) != 0) {
        const float d = first ? mloc : fmaxf(mloc, 0.f);
        const float alpha = fexp2(-d);
        m += d; l *= alpha;
#pragma unroll
        for (int reg = 0; reg < 16; ++reg) { negm[reg] = -m; pt[reg] -= d; }
#pragma unroll
        for (int b = 0; b < DV / 32; ++b)
#pragma unroll
          for (int reg = 0; reg < 16; ++reg) o[b][reg] *= alpha;
      }
      float la = 0.f;
#pragma unroll
      for (int reg = 0; reg < 16; ++reg) { const float e = fexp2(pt[reg]); pt[reg] = e; la += e; }
      l += la;
#pragma unroll
      for (int s2 = 0; s2 < 2; ++s2) {
        const bf16x8 pb = pack8(pt, s2);
        const int s16 = 2 * ks + s2;
#pragma unroll
        for (int b = 0; b < DV / 32; ++b) {
          const char* va = base + KB + b * 4096 + s16 * 1024 + trofs;
          const bf16x8 vf = cat8(vtr(va), vtr(va + 512));
          o[b] = MFMA(vf, pb, o[b]);
        }
      }
    }
  };
  if (DV == 64) {
    A_LOAD(kA, vA, 0);
    A_LOAD(kB, vB, 1);
    A_STORE(kA, vA, 0);
    __syncthreads();
    for (int it = 0; it < ntiles; it += 2) {
      if (it + 2 < ntiles) A_LOAD(kA, vA, it + 2);
      compute(lds, it);
      A_STORE(kB, vB, 1);
      __syncthreads();
      if (it + 3 < ntiles) A_LOAD(kB, vB, it + 3);
      compute(lds + STAGE, it + 1);
      if (it + 2 < ntiles) A_STORE(kA, vA, 0);
      __syncthreads();
    }
  } else {
    A_LOAD(kA, vA, 0);
    A_STORE(kA, vA, 0);
    __syncthreads();
    for (int it = 0; it < ntiles; it += 2) {
      A_LOAD(kA, vA, it + 1);
      compute(lds, it);
      A_STORE(kA, vA, 1);
      __syncthreads();
      if (it + 2 < ntiles) A_LOAD(kA, vA, it + 2);
      compute(lds + STAGE, it + 1);
      if (it + 2 < ntiles) A_STORE(kA, vA, 0);
      __syncthreads();
    }
  }
#undef A_LOAD
#undef A_STORE
  lsum = hsum(l);
}

#define PROW() (P + (tokbase + qs0 + (otid() >> 6) * 32 + (otid() & 31)) * PW)
DI void attn_item(const Params& p, int layer, int kind, int b, int hq, int qs0, char* lds) {
  u16* P = (u16*)(p.ws + OFF_P);
  const int tid = otid(), lane = tid & 63, wid = tid >> 6, r = lane & 31, h = lane >> 5;
  const size_t tokbase = (size_t)b * SU;
  const int sq = qs0 + wid * 32 + r;
  const bool isctx = qs0 < LC;
  if (kind == 2) {
    const int hk = hq >> 1;
    const float lam = ((const float*)(p.ws + OFF_SMALL + SM_LAM))[layer];
    const float li = layer == 0 ? 0.2f : 0.35550906759096927f;
    const int n1 = isctx ? 4 : 68;
#define O1G() (PROW() + C_DQ + hq * 128)
    {
      f32x16 o[4]; float ls;
      stage_q(PROW() + C_DQ + (hq * 2 + 0) * 64, lds);
      attn_core<128>(P, tokbase, C_DK + (hk * 2 + 0) * 64, C_DV + hk * 128, n1, 0, 0, false, 0, -1e30f, 0.f, o, ls, lds);
      const float inv = 1.f / ls;
      stage_q(PROW() + C_DQ + (hq * 2 + 1) * 64, lds);
#pragma unroll
      for (int bk = 0; bk < 4; ++bk)
#pragma unroll
        for (int k2 = 0; k2 < 2; ++k2)
          store8pair(O1G() + 32 * bk + 16 * k2, h, o[bk][8 * k2] * inv, o[bk][8 * k2 + 1] * inv, o[bk][8 * k2 + 2] * inv, o[bk][8 * k2 + 3] * inv,
                     o[bk][8 * k2 + 4] * inv, o[bk][8 * k2 + 5] * inv, o[bk][8 * k2 + 6] * inv, o[bk][8 * k2 + 7] * inv);
    }
    f32x16 o[4]; float ls;
    attn_core<128>(P, tokbase, C_DK + (hk * 2 + 1) * 64, C_DV + hk * 128, n1, 0, 0, false, 0, -1e30f, 0.f, o, ls, lds);
    const float inv2 = lam / ls;
    float ss = 0.f;
#pragma unroll
    for (int bk = 0; bk < 4; ++bk)
#pragma unroll
      for (int k2 = 0; k2 < 2; ++k2) {
        u32x2 tx, ty;
        load8pair(O1G() + 32 * bk + 16 * k2, h, tx, ty);
#pragma unroll
        for (int gg = 0; gg < 2; ++gg) {
          const u32x2 t1 = gg == 0 ? tx : ty;
          const int g4 = 2 * k2 + gg;
          const float a0 = bflo(t1[0]) - o[bk][4 * g4] * inv2, a1 = bfhi(t1[0]) - o[bk][4 * g4 + 1] * inv2;
          const float a2 = bflo(t1[1]) - o[bk][4 * g4 + 2] * inv2, a3 = bfhi(t1[1]) - o[bk][4 * g4 + 3] * inv2;
          o[bk][4 * g4] = a0; o[bk][4 * g4 + 1] = a1; o[bk][4 * g4 + 2] = a2; o[bk][4 * g4 + 3] = a3;
          ss += a0 * a0 + a1 * a1 + a2 * a2 + a3 * a3;
        }
      }
    ss = hsum(ss);
    const float rn = rsqrtf(ss * (1.f / 128.f) + EPS) * (1.f - li);
    const float* sg = p.diff_norm + layer * 128;
#pragma unroll
    for (int bk = 0; bk < 4; ++bk)
#pragma unroll
      for (int k2 = 0; k2 < 2; ++k2) {
        u16* zp = PROW() + C_DZ + hq * 128 + 32 * bk + 16 * k2;
        u32x2 zx, zy;
        load8pair(zp, h, zx, zy);
        const float4 gx = *(const float4*)(sg + 32 * bk + 16 * k2 + 4 * h), gy = *(const float4*)(sg + 32 * bk + 16 * k2 + 8 + 4 * h);
        store8pair(zp, h, o[bk][8 * k2] * rn * gx.x * siluf_(bflo(zx[0])), o[bk][8 * k2 + 1] * rn * gx.y * siluf_(bfhi(zx[0])),
                   o[bk][8 * k2 + 2] * rn * gx.z * siluf_(bflo(zx[1])), o[bk][8 * k2 + 3] * rn * gx.w * siluf_(bfhi(zx[1])),
                   o[bk][8 * k2 + 4] * rn * gy.x * siluf_(bflo(zy[0])), o[bk][8 * k2 + 5] * rn * gy.y * siluf_(bfhi(zy[0])),
                   o[bk][8 * k2 + 6] * rn * gy.z * siluf_(bflo(zy[1])), o[bk][8 * k2 + 7] * rn * gy.w * siluf_(bfhi(zy[1])));
        __builtin_amdgcn_sched_barrier(0);
      }
  } else {
    int qc, kc, vc, zc, n1, n2 = 0, xs0 = 0; bool win = false; float m0 = -1e30f, l0 = 0.f;
    if (kind == 1) { qc = C_CQ + hq * 64; kc = C_CK + (hq >> 1) * 64; vc = C_CV + (hq >> 1) * 64; zc = C_CZ + hq * 64; n1 = isctx ? 4 : 68; }
    else {
      qc = C_BQ + hq * 64; kc = C_BK + (hq >> 2) * 64; vc = C_BV + (hq >> 2) * 64; zc = C_BZ + hq * 64; n1 = 4;
      m0 = p.win_sink[layer * 8 + hq] * LOG2E; l0 = 1.f;
      if (!isctx) {
        const int q0 = qs0 - LC;
        const int lo = q0 - 128 < 0 ? 0 : q0 - 128, hi = q0 + 256 > SEQ ? SEQ : q0 + 256;
        xs0 = LC + lo; n2 = (hi - lo) >> 6; win = true;
      }
    }
    f32x16 o[2]; float ls;
    stage_q(PROW() + qc, lds);
    attn_core<64>(P, tokbase, kc, vc, n1, n2, xs0, win, sq - LC, m0, l0, o, ls, lds);
    const float inv = 1.f / ls;
#pragma unroll
    for (int bk = 0; bk < 2; ++bk)
#pragma unroll
      for (int k2 = 0; k2 < 2; ++k2) {
        u16* zp = PROW() + zc + 32 * bk + 16 * k2;
        u32x2 zx, zy;
        load8pair(zp, h, zx, zy);
        store8pair(zp, h, o[bk][8 * k2] * inv * siluf_(bflo(zx[0])), o[bk][8 * k2 + 1] * inv * siluf_(bfhi(zx[0])),
                   o[bk][8 * k2 + 2] * inv * siluf_(bflo(zx[1])), o[bk][8 * k2 + 3] * inv * siluf_(bfhi(zx[1])),
                   o[bk][8 * k2 + 4] * inv * siluf_(bflo(zy[0])), o[bk][8 * k2 + 5] * inv * siluf_(bfhi(zy[0])),
                   o[bk][8 * k2 + 6] * inv * siluf_(bflo(zy[1])), o[bk][8 * k2 + 7] * inv * siluf_(bfhi(zy[1])));
        __builtin_amdgcn_sched_barrier(0);
      }
  }
}

#undef PROW
#undef O1G
DI void attn_core2(const u16* __restrict__ P, size_t tokbase, int kcol, int vcol, int n1, int n2, int xs0, bool win, int tq0,
                   float m0, float l0, const bf16x8 (&qreg)[2][4], f32x16 (&o)[2][2], float (&lsum)[2], char* lds) {
  constexpr int KB = 8192, STAGE = 16384;
  constexpr float THR = 12.f;
  const int tid = otid(), lane = tid & 63, r = lane & 31, h = lane >> 5;
  u32x4 kA[2], vA[2];
  const int ntiles = n1 + n2;
  const int kkey = tid >> 3, kch = tid & 7;
  const bool autoinit = (l0 == 0.f);
  float m[2], l[2];
  bool mz[2];
#pragma unroll
  for (int qs = 0; qs < 2; ++qs) { m[qs] = autoinit ? 0.f : m0; mz[qs] = autoinit; l[qs] = (h == 0) ? l0 : 0.f; o[qs][0] = fzero(); o[qs][1] = fzero(); }
  const int trofs = (4 * h + ((lane & 15) >> 2)) * 64 + ((lane >> 4) & 1) * 32 + (lane & 3) * 8;
#define A_LOAD(kr, vr, t_)                                                                                          \
  {                                                                                                                 \
    const int s0_ = ((t_) < n1) ? (t_) * 64 : xs0 + ((t_) - n1) * 64;                                               \
    const u16* kb_ = P + (tokbase + s0_) * PW;                                                                      \
    _Pragma("unroll") for (int i = 0; i < 2; ++i) kr[i] = *(const u32x4*)(kb_ + (size_t)(kkey + 32 * i) * PW + kcol + kch * 8);  \
    _Pragma("unroll") for (int i = 0; i < 2; ++i) vr[i] = *(const u32x4*)(kb_ + (size_t)(kkey + 32 * i) * PW + vcol + kch * 8);  \
  }
#define A_STORE(kr, vr, buf_)                                                                                       \
  {                                                                                                                 \
    char* nb_ = lds + (buf_) * STAGE;                                                                               \
    _Pragma("unroll") for (int i = 0; i < 2; ++i) { int key = kkey + 32 * i; *(u32x4*)(nb_ + kch * 1024 + ((key ^ kch) * 16)) = kr[i]; }   \
    _Pragma("unroll") for (int i = 0; i < 2; ++i) { int key = kkey + 32 * i; *(u32x4*)(nb_ + KB + (kch >> 2) * 4096 + key * 64 + (kch & 3) * 16) = vr[i]; } \
  }
  auto compute = [&](const char* base, int it) __attribute__((always_inline)) {
    const bool domask = win && it >= n1;
    const int kt0 = xs0 + (it - n1) * 64 - LC;
#pragma unroll
    for (int ks = 0; ks < 2; ++ks) {
      f32x16 pt[2]; pt[0] = fzero(); pt[1] = fzero();
#pragma unroll
      for (int s = 0; s < 4; ++s) {
        const int ch = 2 * s + h, key = 32 * ks + r;
        const bf16x8 kf = *(const bf16x8*)(base + ch * 1024 + ((key ^ ch) * 16));
        pt[0] = MFMA(kf, qreg[0][s], pt[0]);
        pt[1] = MFMA(kf, qreg[1][s], pt[1]);
      }
#pragma unroll
      for (int qs = 0; qs < 2; ++qs) {
        if (domask) {
#pragma unroll
          for (int reg = 0; reg < 16; ++reg) {
            const int d = tq0 + 32 * qs - (kt0 + 32 * ks + crow(reg, h));
            if (d > 128 || d < -128) pt[qs][reg] = -1e30f;
          }
        }
        float mloc = mx2(pt[qs][0], pt[qs][1]);
#pragma unroll
        for (int reg = 2; reg < 16; reg += 2) mloc = mx2(mx2(mloc, pt[qs][reg]), pt[qs][reg + 1]);
        mloc = hmax(mloc) - m[qs];
        if (__builtin_amdgcn_ballot_w64(mloc > THR) != 0) {
          const float d = fmaxf(mloc, 0.f);
          const float alpha = fexp2(-d);
          m[qs] += d; l[qs] *= alpha; mz[qs] = false;
#pragma unroll
          for (int b = 0; b < 2; ++b)
#pragma unroll
            for (int reg = 0; reg < 16; ++reg) o[qs][b][reg] *= alpha;
        }
        float la = 0.f;
        if (mz[qs]) {
#pragma unroll
          for (int reg = 0; reg < 16; ++reg) { const float e = fexp2(pt[qs][reg]); pt[qs][reg] = e; la += e; }
        } else {
#pragma unroll
          for (int reg = 0; reg < 16; ++reg) { const float e = fexp2(pt[qs][reg] - m[qs]); pt[qs][reg] = e; la += e; }
        }
        l[qs] += la;
      }
#pragma unroll
      for (int s2 = 0; s2 < 2; ++s2) {
        const bf16x8 pb0 = pack8(pt[0], s2), pb1 = pack8(pt[1], s2);
        const int s16 = 2 * ks + s2;
#pragma unroll
        for (int b = 0; b < 2; ++b) {
          const char* va = base + KB + b * 4096 + s16 * 1024 + trofs;
          const bf16x8 vf = cat8(vtr(va), vtr(va + 512));
          o[0][b] = MFMA(vf, pb0, o[0][b]);
          o[1][b] = MFMA(vf, pb1, o[1][b]);
        }
      }
    }
  };
  A_LOAD(kA, vA, 0);
  A_STORE(kA, vA, 0);
  __syncthreads();
  for (int it = 0; it < ntiles; it += 2) {
    A_LOAD(kA, vA, it + 1);
    compute(lds, it);
    A_STORE(kA, vA, 1);
    __syncthreads();
    if (it + 2 < ntiles) A_LOAD(kA, vA, it + 2);
    compute(lds + STAGE, it + 1);
    if (it + 2 < ntiles) A_STORE(kA, vA, 0);
    __syncthreads();
  }
#undef A_LOAD
#undef A_STORE
  lsum[0] = hsum(l[0]); lsum[1] = hsum(l[1]);
}

DI void attn_item2(const Params& p, int layer, int kind, int b, int hq, int qs0, char* lds) {
  u16* P = (u16*)(p.ws + OFF_P);
  const int tid = otid(), lane = tid & 63, wid = tid >> 6, r = lane & 31, h = lane >> 5;
  const size_t tokbase = (size_t)b * SU;
  const bool isctx = qs0 < LC;
#define PROW2(qs_) (P + (tokbase + qs0 + (otid() >> 6) * 64 + 32 * (qs_) + (otid() & 31)) * PW)
  int qc, kc, vc, zc, n1, n2 = 0, xs0 = 0; bool win = false; float m0 = -1e30f, l0 = 0.f;
  if (kind == 1) { qc = C_CQ + hq * 64; kc = C_CK + (hq >> 1) * 64; vc = C_CV + (hq >> 1) * 64; zc = C_CZ + hq * 64; n1 = isctx ? 4 : 68; }
  else {
    qc = C_BQ + hq * 64; kc = C_BK + (hq >> 2) * 64; vc = C_BV + (hq >> 2) * 64; zc = C_BZ + hq * 64; n1 = 4;
    m0 = p.win_sink[layer * 8 + hq] * LOG2E; l0 = 1.f;
    if (!isctx) {
      const int q0 = qs0 - LC;
      const int lo = q0 - 128 < 0 ? 0 : q0 - 128, hi = q0 + 384 > SEQ ? SEQ : q0 + 384;
      xs0 = LC + lo; n2 = (hi - lo) >> 6; win = true;
    }
  }
  bf16x8 qreg[2][4];
  {
    const char* qlds = lds + 49152 + wid * 4096;
#pragma unroll
    for (int qs = 0; qs < 2; ++qs) {
      stage_q(PROW2(qs) + qc, lds);
#pragma unroll
      for (int s = 0; s < 4; ++s) { const int ch = 2 * s + h; qreg[qs][s] = *(const bf16x8*)(qlds + ch * 512 + ((r ^ ch) * 16)); }
    }
  }
  __syncthreads();
  f32x16 o[2][2]; float ls[2];
  attn_core2(P, tokbase, kc, vc, n1, n2, xs0, win, qs0 + wid * 64 + r - LC, m0, l0, qreg, o, ls, lds);
#pragma unroll
  for (int qs = 0; qs < 2; ++qs) {
    const float inv = 1.f / ls[qs];
#pragma unroll
    for (int bk = 0; bk < 2; ++bk)
#pragma unroll
      for (int k2 = 0; k2 < 2; ++k2) {
        u16* zp = PROW2(qs) + zc + 32 * bk + 16 * k2;
        u32x2 zx, zy;
        load8pair(zp, h, zx, zy);
        store8pair(zp, h, o[qs][bk][8 * k2] * inv * siluf_(bflo(zx[0])), o[qs][bk][8 * k2 + 1] * inv * siluf_(bfhi(zx[0])),
                   o[qs][bk][8 * k2 + 2] * inv * siluf_(bflo(zx[1])), o[qs][bk][8 * k2 + 3] * inv * siluf_(bfhi(zx[1])),
                   o[qs][bk][8 * k2 + 4] * inv * siluf_(bflo(zy[0])), o[qs][bk][8 * k2 + 5] * inv * siluf_(bfhi(zy[0])),
                   o[qs][bk][8 * k2 + 6] * inv * siluf_(bflo(zy[1])), o[qs][bk][8 * k2 + 7] * inv * siluf_(bfhi(zy[1])));
        __builtin_amdgcn_sched_barrier(0);
      }
  }
#undef PROW2
}

DI void gla_prep(const Params& p, int layer, int b, int hd, int c, char* lds) {
  u16* P = (u16*)(p.ws + OFF_P);
  u16* TMP = (u16*)(p.ws + OFF_GTMP);
  float* DECG = (float*)(p.ws + OFF_DEC);
  const int tid = otid();
  float* G = (float*)lds;
  float* WG = (float*)(lds + 8192);
  float* LAF = (float*)(lds + 17408);
  float* LAB = (float*)(lds + 33792);
  float* CS = (float*)(lds + 50176);
  const size_t tokbase = (size_t)b * SU + 64 * c;
  for (int e = tid; e < 2048; e += 256) { const int d = e >> 10, rr = (e >> 6) & 15, k = e & 63; WG[e] = p.gla_w_gate[(size_t)((layer * 2 + d) * 16 + rr) * 256 + hd * 64 + k]; }
  if (tid < 128) WG[2048 + tid] = p.gla_b_gate[(layer * 2 + (tid >> 6)) * 256 + hd * 64 + (tid & 63)];
  {
    const int tok = tid >> 2, part = tid & 3;
    const u32x4 gv = *(const u32x4*)(P + (tokbase + tok) * PW + C_AG + part * 8);
    float* gp = G + tok * 32 + part * 8;
    *(float4*)gp = make_float4(bflo(gv[0]), bfhi(gv[0]), bflo(gv[1]), bfhi(gv[1]));
    *(float4*)(gp + 4) = make_float4(bflo(gv[2]), bfhi(gv[2]), bflo(gv[3]), bfhi(gv[3]));
  }
  const int tp = tid >> 3, cg8 = (tid & 7) * 8;
  u32x4 qv[2], kv[2];
#pragma unroll
  for (int t = 0; t < 2; ++t) {
    const u16* rp = P + (tokbase + 2 * tp + t) * PW + hd * 64 + cg8;
    qv[t] = *(const u32x4*)(rp + C_AQ); kv[t] = *(const u32x4*)(rp + C_AK);
  }
  __syncthreads();
#pragma unroll
  for (int t = 0; t < 2; ++t) {
    const int tok = 2 * tp + t;
    float pf[8], pb[8];
    {
      const float4 b0 = *(const float4*)(WG + 2048 + cg8), b1 = *(const float4*)(WG + 2048 + cg8 + 4);
      const float4 c0 = *(const float4*)(WG + 2112 + cg8), c1 = *(const float4*)(WG + 2112 + cg8 + 4);
      pf[0] = b0.x; pf[1] = b0.y; pf[2] = b0.z; pf[3] = b0.w; pf[4] = b1.x; pf[5] = b1.y; pf[6] = b1.z; pf[7] = b1.w;
      pb[0] = c0.x; pb[1] = c0.y; pb[2] = c0.z; pb[3] = c0.w; pb[4] = c1.x; pb[5] = c1.y; pb[6] = c1.z; pb[7] = c1.w;
    }
#pragma unroll 4
    for (int rr = 0; rr < 16; ++rr) {
      const float gf = G[tok * 32 + rr], gb = G[tok * 32 + 16 + rr];
      const float4 w0 = *(const float4*)(WG + rr * 64 + cg8), w1 = *(const float4*)(WG + rr * 64 + cg8 + 4);
      const float4 v0 = *(const float4*)(WG + 1024 + rr * 64 + cg8), v1 = *(const float4*)(WG + 1024 + rr * 64 + cg8 + 4);
      pf[0] += gf * w0.x; pf[1] += gf * w0.y; pf[2] += gf * w0.z; pf[3] += gf * w0.w; pf[4] += gf * w1.x; pf[5] += gf * w1.y; pf[6] += gf * w1.z; pf[7] += gf * w1.w;
      pb[0] += gb * v0.x; pb[1] += gb * v0.y; pb[2] += gb * v0.z; pb[3] += gb * v0.w; pb[4] += gb * v1.x; pb[5] += gb * v1.y; pb[6] += gb * v1.z; pb[7] += gb * v1.w;
    }
#pragma unroll
    for (int e = 0; e < 8; ++e) {
      pf[e] = (fminf(pf[e], 0.f) - __logf(1.f + __expf(-fabsf(pf[e])))) * (1.f / 16.f);
      pb[e] = (fminf(pb[e], 0.f) - __logf(1.f + __expf(-fabsf(pb[e])))) * (1.f / 16.f);
    }
    *(float4*)(LAF + tok * 64 + cg8) = make_float4(pf[0], pf[1], pf[2], pf[3]); *(float4*)(LAF + tok * 64 + cg8 + 4) = make_float4(pf[4], pf[5], pf[6], pf[7]);
    *(float4*)(LAB + tok * 64 + cg8) = make_float4(pb[0], pb[1], pb[2], pb[3]); *(float4*)(LAB + tok * 64 + cg8 + 4) = make_float4(pb[4], pb[5], pb[6], pb[7]);
  }
  __syncthreads();
  {
    const int ch = tid & 63, q4 = tid >> 6;
    float run = 0.f;
#pragma unroll
    for (int i = 0; i < 16; ++i) { run += LAF[(16 * q4 + i) * 64 + ch]; LAF[(16 * q4 + i) * 64 + ch] = run; }
    CS[q4 * 64 + ch] = run;
    run = 0.f;
#pragma unroll
    for (int i = 15; i >= 0; --i) { run += LAB[(16 * q4 + i) * 64 + ch]; LAB[(16 * q4 + i) * 64 + ch] = run; }
    CS[256 + q4 * 64 + ch] = run;
  }
  __syncthreads();
  {
    const int qq = tp >> 3;
    float pre_f[8], pre_b[8], tot_f[8], tot_b[8];
#pragma unroll
    for (int e = 0; e < 8; ++e) { pre_f[e] = 0.f; pre_b[e] = 0.f; tot_f[e] = 0.f; tot_b[e] = 0.f; }
#pragma unroll
    for (int q = 0; q < 4; ++q) {
#pragma unroll
      for (int e = 0; e < 8; ++e) {
        const float vf_ = CS[q * 64 + cg8 + e], vb_ = CS[256 + q * 64 + cg8 + e];
        tot_f[e] += vf_; tot_b[e] += vb_;
        if (q < qq) pre_f[e] += vf_;
        if (q > qq) pre_b[e] += vb_;
      }
    }
#pragma unroll
    for (int t = 0; t < 2; ++t) {
      const int tok = 2 * tp + t;
      u32x4 oqf, okf, oqb, okb;
#pragma unroll
      for (int e2 = 0; e2 < 4; ++e2) {
        const float q0 = bflo(qv[t][e2]), q1 = bfhi(qv[t][e2]), k0 = bflo(kv[t][e2]), k1 = bfhi(kv[t][e2]);
        const float cf0 = pre_f[2 * e2] + LAF[tok * 64 + cg8 + 2 * e2], cf1 = pre_f[2 * e2 + 1] + LAF[tok * 64 + cg8 + 2 * e2 + 1];
        const float cb0 = pre_b[2 * e2] + LAB[tok * 64 + cg8 + 2 * e2], cb1 = pre_b[2 * e2 + 1] + LAB[tok * 64 + cg8 + 2 * e2 + 1];
        oqf[e2] = cvtpk(q0 * __expf(cf0), q1 * __expf(cf1)); okf[e2] = cvtpk(k0 * __expf(-cf0), k1 * __expf(-cf1));
        oqb[e2] = cvtpk(q0 * __expf(cb0), q1 * __expf(cb1)); okb[e2] = cvtpk(k0 * __expf(-cb0), k1 * __expf(-cb1));
        __builtin_amdgcn_sched_barrier(0);
      }
      u16* pf_ = P + (tokbase + tok) * PW + hd * 64 + cg8;
      u16* pb_ = TMP + (tokbase + tok) * 512 + hd * 64 + cg8;
      *(u32x4*)(pf_ + C_AQ) = oqf; *(u32x4*)(pf_ + C_AK) = okf;
      *(u32x4*)pb_ = oqb; *(u32x4*)(pb_ + 256) = okb;
    }
    if (tp == 0) {
#pragma unroll
      for (int e = 0; e < 8; ++e) {
        DECG[((size_t)((b * 4 + hd) * 2 + 0) * 68 + c) * 64 + cg8 + e] = expf(tot_f[e]);
        DECG[((size_t)((b * 4 + hd) * 2 + 1) * 68 + c) * 64 + cg8 + e] = expf(tot_b[e]);
      }
    }
  }
  __syncthreads();
}

DI void gla_chain(const Params& p, int layer, int b, int hd, int dir, char* lds) {
  u16* P = (u16*)(p.ws + OFF_P);
  const u16* TMP = (const u16*)(p.ws + OFF_GTMP);
  const float* DECG = (const float*)(p.ws + OFF_DEC) + (size_t)((b * 4 + hd) * 2 + dir) * 68 * 64;
  const int tid = otid(), lane = tid & 63, w = tid >> 6, r = lane & 31, h = lane >> 5;
  char* QT = lds; char* KT = lds + 9216; char* KH = lds + 18432; char* VV = lds + 26624; float* DEC = (float*)(lds + 43008);
  const size_t tokbase = (size_t)b * SU;
  const u16* qsrc = dir == 0 ? P + C_AQ + hd * 64 : TMP + hd * 64;
  const u16* ksrc = dir == 0 ? P + C_AK + hd * 64 : TMP + 256 + hd * 64;
  const int qst = dir == 0 ? PW : 512;
  const u16* vsrc = P + C_AV + hd * 128;
  u16* odst = P + (dir == 0 ? C_DQ : C_DK) + hd * 128;
  const int trofs = (4 * h + ((lane & 15) >> 2)) * 64 + ((lane >> 4) & 1) * 32 + (lane & 3) * 8;
  f32x16 S[2]; S[0] = fzero(); S[1] = fzero();
  u32x4 rq[2], rk[2], rv[4]; float rdec = 0.f;
  const int sdir = dir == 0 ? 1 : -1;
#define GLA_LOAD(n_)                                                                                               \
  {                                                                                                                \
    const int c_ = dir == 0 ? (n_) : ((n_) < 4 ? 3 - (n_) : 71 - (n_));                                              \
    const int sb_ = dir == 0 ? 64 * c_ : 64 * c_ + 63;                                                             \
    _Pragma("unroll") for (int it = 0; it < 2; ++it) {                                                             \
      const int id = tid + 256 * it, tok = id >> 3, pc = id & 7;                                                   \
      const size_t row = tokbase + sb_ + sdir * tok;                                                               \
      rq[it] = *(const u32x4*)(qsrc + row * qst + pc * 8);                                                         \
      rk[it] = *(const u32x4*)(ksrc + row * qst + pc * 8);                                                         \
    }                                                                                                              \
    _Pragma("unroll") for (int it = 0; it < 4; ++it) {                                                             \
      const int id = tid + 256 * it, tok = id >> 4, pc = id & 15;                                                  \
      rv[it] = *(const u32x4*)(vsrc + (tokbase + sb_ + sdir * tok) * PW + pc * 8);                                 \
    }                                                                                                              \
    if (tid < 64) rdec = DECG[c_ * 64 + tid];                                                                      \
  }
  GLA_LOAD(0);
  for (int n = 0; n < 68; ++n) {
    int nopq = n; asm volatile("" : "+s"(nopq));
    const int c = dir == 0 ? nopq : (nopq < 4 ? 3 - nopq : 71 - nopq);
    const int sbase = dir == 0 ? 64 * c : 64 * c + 63;
    __syncthreads();
#pragma unroll
    for (int it = 0; it < 2; ++it) {
      const int id = tid + 256 * it, tok = id >> 3, pc = id & 7;
      *(u32x4*)(QT + tok * 144 + pc * 16) = rq[it];
      *(u32x4*)(KT + tok * 144 + pc * 16) = rk[it];
      *(u32x4*)(KH + (pc >> 2) * 4096 + tok * 64 + (pc & 3) * 16) = rk[it];
    }
#pragma unroll
    for (int it = 0; it < 4; ++it) {
      const int id = tid + 256 * it, tok = id >> 4, pc = id & 15;
      *(u32x4*)(VV + (pc >> 2) * 4096 + tok * 64 + (pc & 3) * 16) = rv[it];
    }
    if (tid < 64) DEC[tid] = rdec;
    __syncthreads();
    if (n + 1 < 68) GLA_LOAD(nopq + 1);
    bf16x8 qf[2][4];
#pragma unroll
    for (int cs = 0; cs < 2; ++cs)
#pragma unroll
      for (int sp = 0; sp < 4; ++sp) {
        const char* a = QT + (32 * cs + r) * 144 + (16 * sp + 4 * h) * 2;
        qf[cs][sp] = cat8(*(const s16x4*)a, *(const s16x4*)(a + 16));
      }
    bf16x8 vf[4];
#pragma unroll
    for (int s16 = 0; s16 < 4; ++s16) { const char* va = VV + w * 4096 + s16 * 1024 + trofs; vf[s16] = cat8(vtr(va), vtr(va + 512)); }
    f32x16 o0 = fzero(), o1 = fzero();
#pragma unroll
    for (int tix = 0; tix < 3; ++tix) {
      const int ssub = tix == 2 ? 1 : 0, csub = tix == 0 ? 0 : 1;
      f32x16 at = fzero();
#pragma unroll
      for (int sp = 0; sp < 4; ++sp) {
        const char* a0 = KT + (32 * ssub + r) * 144 + (16 * sp + 4 * h) * 2;
        const bf16x8 kf0 = cat8(*(const s16x4*)a0, *(const s16x4*)(a0 + 16));
        at = MFMA(kf0, qf[csub][sp], at);
      }
      if (ssub == csub) {
#pragma unroll
        for (int reg = 0; reg < 16; ++reg) if (crow(reg, h) > r) at[reg] = 0.f;
      }
#pragma unroll
      for (int s2 = 0; s2 < 2; ++s2) {
        if (csub == 0) o0 = MFMA(vf[2 * ssub + s2], pack8(at, s2), o0);
        else o1 = MFMA(vf[2 * ssub + s2], pack8(at, s2), o1);
      }
    }
#pragma unroll
    for (int i = 0; i < 2; ++i)
#pragma unroll
      for (int s2 = 0; s2 < 2; ++s2) {
        const bf16x8 sp8 = pack8(S[i], s2);
        o0 = MFMA(sp8, qf[0][2 * i + s2], o0);
        o1 = MFMA(sp8, qf[1][2 * i + s2], o1);
      }
#pragma unroll
    for (int i = 0; i < 2; ++i) {
#pragma unroll
      for (int s16 = 0; s16 < 4; ++s16) {
        const char* ka = KH + i * 4096 + s16 * 1024 + trofs;
        const bf16x8 khf = cat8(vtr(ka), vtr(ka + 512));
        S[i] = MFMA(khf, vf[s16], S[i]);
      }
#pragma unroll
      for (int g4 = 0; g4 < 4; ++g4) {
        const float4 d4 = *(const float4*)(DEC + 32 * i + 8 * g4 + 4 * h);
        S[i][4 * g4] *= d4.x; S[i][4 * g4 + 1] *= d4.y; S[i][4 * g4 + 2] *= d4.z; S[i][4 * g4 + 3] *= d4.w;
      }
    }
    int lo_ = lane; asm volatile("" : "+v"(lo_));
    const int r2 = lo_ & 31, h2 = lo_ >> 5;
#pragma unroll
    for (int cs = 0; cs < 2; ++cs) {
      const f32x16& oo = cs == 0 ? o0 : o1;
      const size_t tok = tokbase + sbase + sdir * (32 * cs + r2);
#pragma unroll
      for (int k2 = 0; k2 < 2; ++k2)
        store8pair(odst + tok * PW + 32 * w + 16 * k2, h2, oo[8 * k2], oo[8 * k2 + 1], oo[8 * k2 + 2], oo[8 * k2 + 3], oo[8 * k2 + 4], oo[8 * k2 + 5], oo[8 * k2 + 6], oo[8 * k2 + 7]);
    }
  }
#undef GLA_LOAD
  asm volatile("s_waitcnt vmcnt(0)" ::: "memory");
  __syncthreads();
  if (tid == 0) {
    __builtin_amdgcn_fence(__ATOMIC_RELEASE, "agent");
    asm volatile("s_waitcnt vmcnt(0)" ::: "memory");
    __hip_atomic_fetch_add((int*)(p.ws + OFF_SMALL + SM_CTR) + 32 + layer * 32 + b * 4 + hd, 1, __ATOMIC_RELAXED, __HIP_MEMORY_SCOPE_AGENT);
  }
}

DI void gla_combine(const Params& p, int layer, int b, int hd, int tile, char* lds) {
  u16* P = (u16*)(p.ws + OFF_P);
  const int tid = otid();
  int* flag = (int*)(p.ws + OFF_SMALL + SM_CTR) + 32 + layer * 32 + b * 4 + hd;
  if (tid == 0) {
    while (__hip_atomic_load(flag, __ATOMIC_RELAXED, __HIP_MEMORY_SCOPE_AGENT) < 2) __builtin_amdgcn_s_sleep(8);
    __builtin_amdgcn_fence(__ATOMIC_ACQUIRE, "agent");
    asm volatile("s_waitcnt vmcnt(0)" ::: "memory");
  }
  __syncthreads();
  const int sub = tid & 15, tl = tid >> 4, lane = tid & 63;
  const float* ng = p.gla_norm + layer * 512 + hd * 128 + sub * 8;
  const float4 g0 = *(const float4*)ng, g1 = *(const float4*)(ng + 4);
#pragma unroll 2
  for (int ps = 0; ps < 8; ++ps) {
    u16* row = P + ((size_t)b * SU + tile * 128 + ps * 16 + tl) * PW + hd * 128 + sub * 8;
    const u32x4 a = *(const u32x4*)(row + C_DQ), bq = *(const u32x4*)(row + C_DK), z = *(const u32x4*)(row + C_AZ);
    float v[8]; float ss = 0.f;
#pragma unroll
    for (int k = 0; k < 4; ++k) {
      v[2 * k] = bflo(a[k]) + bflo(bq[k]); v[2 * k + 1] = bfhi(a[k]) + bfhi(bq[k]);
      ss += v[2 * k] * v[2 * k] + v[2 * k + 1] * v[2 * k + 1];
    }
    ss += shx(ss, 1, lane); ss += shx(ss, 2, lane); ss += shx(ss, 4, lane); ss += shx(ss, 8, lane);
    const float rn = rsqrtf(ss * (1.f / 128.f) + EPS);
    u32x4 o;
    o[0] = cvtpk(v[0] * rn * g0.x * siluf_(bflo(z[0])), v[1] * rn * g0.y * siluf_(bfhi(z[0])));
    o[1] = cvtpk(v[2] * rn * g0.z * siluf_(bflo(z[1])), v[3] * rn * g0.w * siluf_(bfhi(z[1])));
    o[2] = cvtpk(v[4] * rn * g1.x * siluf_(bflo(z[2])), v[5] * rn * g1.y * siluf_(bfhi(z[2])));
    o[3] = cvtpk(v[6] * rn * g1.z * siluf_(bflo(z[3])), v[7] * rn * g1.w * siluf_(bfhi(z[3])));
    *(u32x4*)(row + C_AZ) = o;
  }
}

DI void phase_mix(const Params& p, int layer, int sub, char* lds) {
  int& s_item = *(int*)(lds + 65536);
  int* ctrs = (int*)(p.ws + OFF_SMALL + SM_CTR) + (layer * 2 + sub) * 8;
  const int total = sub == 0 ? (layer == 0 ? 272 + 128 + 24 : 272 + 128) : 8 + 256 + 136;
  for (int qi = 0; qi < 8; ++qi) {
    const int b = (blockIdx.x + qi) & 7;
    for (;;) {
      if (threadIdx.x == 0) s_item = atomicAdd(ctrs + b, 1);
      __syncthreads();
      const int item = s_item;
      __syncthreads();
      if (item >= total) break;
      if (sub == 0) {
        if (item < 272) gla_prep(p, layer, b, item / 68, item % 68, lds);
        else if (item < 400) { const int id = item - 272; attn_item(p, layer, 2, b, id >> 5, LC + (id & 31) * 128, lds); }
        else if (item < 408) { const int id = item - 400; attn_item(p, layer, 2, b, id >> 1, (id & 1) * 128, lds); }
        else if (item < 416) attn_item2(p, layer, 1, b, item - 408, 0, lds);
        else attn_item2(p, layer, 0, b, item - 416, 0, lds);
      } else {
        if (item < 8) gla_chain(p, layer, b, item & 3, item < 4 ? 1 : 0, lds);
        else if (item < 72) { const int id = item - 8; attn_item2(p, layer, 1, b, id >> 4, LC + (id & 15) * 256, lds); }
        else if (item >= 208 && item < 272) { const int id = item - 208 + 64; attn_item2(p, layer, 1, b, id >> 4, LC + (id & 15) * 256, lds); }
        else if (item >= 272) { const int id = item - 272; attn_item2(p, layer, 0, b, id >> 4, LC + (id & 15) * 256, lds); }
        else { const int id = item - 72; gla_combine(p, layer, b, id / 34, id % 34, lds); }
      }
    }
  }
}

template <int TJ>
DI void merge_tile(const Params& p, size_t t0, int nt, char* lds) {
  const u16* Wm = (const u16*)(p.ws + OFF_WM); const u16* Wu = (const u16*)(p.ws + OFF_WU);
  const u16* H = (const u16*)(p.ws + OFF_H); u16* P = (u16*)(p.ws + OFF_P);
  const int tid = otid(), lane = tid & 63, wid = tid >> 6, r = lane & 31, h = lane >> 5;
  const int wn = wid & 1, wt = wid >> 1;
  f32x16 ms[2][TJ];
#pragma unroll
  for (int i = 0; i < 2; ++i)
#pragma unroll
    for (int j = 0; j < TJ; ++j) ms[i][j] = fzero();
#pragma unroll 1
  for (int br = 0; br < 4; ++br) {
    const int zc = br == 0 ? C_AZ : br == 1 ? C_BZ : br == 2 ? C_CZ : C_DZ;
    f32x16 ag[2][TJ];
#pragma unroll
    for (int i = 0; i < 2; ++i)
#pragma unroll
      for (int j = 0; j < TJ; ++j) ag[i][j] = fzero();
    gemm_core<TJ>(Wm + ((size_t)br * 1024 + nt * 128) * 1024, 1024, H + t0 * 1024, 1024, 1024, ag, lds);
    unsigned* sgl = (unsigned*)(lds + 32768) + tid;
#pragma unroll
    for (int i = 0; i < 2; ++i)
#pragma unroll
      for (int j = 0; j < TJ; ++j)
#pragma unroll
        for (int e = 0; e < 8; ++e) sgl[((i * TJ + j) * 8 + e) * 256] = cvtpk(sigmoidf_(ag[i][j][2 * e]), sigmoidf_(ag[i][j][2 * e + 1]));
#pragma unroll
    for (int i = 0; i < 2; ++i)
#pragma unroll
      for (int j = 0; j < TJ; ++j) ag[i][j] = fzero();
    gemm_core<TJ>(Wu + ((size_t)br * 1024 + nt * 128) * 512, 512, P + t0 * PW + zc, PW, 512, ag, lds);
#pragma unroll
    for (int i = 0; i < 2; ++i)
#pragma unroll
      for (int j = 0; j < TJ; ++j)
#pragma unroll
        for (int e = 0; e < 8; ++e) { const unsigned sv = sgl[((i * TJ + j) * 8 + e) * 256]; ms[i][j][2 * e] += bflo(sv) * ag[i][j][2 * e]; ms[i][j][2 * e + 1] += bfhi(sv) * ag[i][j][2 * e + 1]; }
  }
#pragma unroll
  for (int i = 0; i < 2; ++i)
#pragma unroll
    for (int j = 0; j < TJ; ++j) {
      const size_t tok = t0 + wt * (32 * TJ) + 32 * j + r;
#pragma unroll
      for (int k2 = 0; k2 < 2; ++k2)
        store8pair(P + tok * PW + nt * 128 + wn * 64 + 32 * i + 16 * k2, h, ms[i][j][8 * k2], ms[i][j][8 * k2 + 1], ms[i][j][8 * k2 + 2], ms[i][j][8 * k2 + 3],
                   ms[i][j][8 * k2 + 4], ms[i][j][8 * k2 + 5], ms[i][j][8 * k2 + 6], ms[i][j][8 * k2 + 7]);
    }
}
DI void phase_merge(const Params& p, int layer, char* lds) {
  const int ntile = layer == 0 ? 2304 : 2048;
  (void)ntile;
  const int b = blockIdx.x & 7, li = blockIdx.x >> 3, nloc = gridDim.x >> 3;
  const int nq = layer == 0 ? 288 : 256;
  for (int q = li; q < nq; q += nloc) {
    if (q < 256) merge_tile<2>(p, (size_t)b * SU + LC + (size_t)(q >> 3) * 128, q & 7, lds);
    else merge_tile<1>(p, (size_t)b * SU + (size_t)((q - 256) >> 3) * 64, q & 7, lds);
  }
}

template <int TJ>
DI void out_tile(const Params& p, int layer, size_t t0, int nt, char* lds) {
  const u16* Wo = (const u16*)(p.ws + OFF_WO); u16* P = (u16*)(p.ws + OFF_P);
  const float* mod = (const float*)(p.ws + OFF_SMALL + SM_MOD) + (size_t)layer * 9 * 3072;
  const int tid = otid(), lane = tid & 63, wid = tid >> 6, h = lane >> 5;
  const int wn = wid & 1;
  f32x16 acc[2][TJ];
#pragma unroll
  for (int i = 0; i < 2; ++i)
#pragma unroll
    for (int j = 0; j < TJ; ++j) acc[i][j] = fzero();
  gemm_core<TJ>(Wo + (size_t)nt * 128 * 1024, 1024, P + t0 * PW, PW, 1024, acc, lds);
  const int b = (int)(t0 / SU), s0 = (int)(t0 % SU);
  const float* gt = mod + (s0 >= LC ? b : 8) * 3072 + 2048 + nt * 128 + wn * 64;
#pragma unroll
  for (int j = 0; j < TJ; ++j) {
    const int t2_ = otid();
    const size_t tok = t0 + (t2_ >> 7) * (32 * TJ) + 32 * j + (t2_ & 31);
#pragma unroll
    for (int i = 0; i < 2; ++i)
#pragma unroll
      for (int k2 = 0; k2 < 2; ++k2) {
        const float4 gx = *(const float4*)(gt + 32 * i + 16 * k2 + 4 * h), gy = *(const float4*)(gt + 32 * i + 16 * k2 + 8 + 4 * h);
        store8pair(P + tok * PW + 1024 + nt * 128 + wn * 64 + 32 * i + 16 * k2, h,
                   gx.x * acc[i][j][8 * k2], gx.y * acc[i][j][8 * k2 + 1], gx.z * acc[i][j][8 * k2 + 2], gx.w * acc[i][j][8 * k2 + 3],
                   gy.x * acc[i][j][8 * k2 + 4], gy.y * acc[i][j][8 * k2 + 5], gy.z * acc[i][j][8 * k2 + 6], gy.w * acc[i][j][8 * k2 + 7]);
      }
  }
}
DI void phase_out(const Params& p, int layer, char* lds) {
  const int ntile = layer == 0 ? 1280 : 1024;
  (void)ntile;
  const int b = blockIdx.x & 7, li = blockIdx.x >> 3, nloc = gridDim.x >> 3;
  const int nq = layer == 0 ? 160 : 128;
  for (int q = li; q < nq; q += nloc) {
    if (q < 128) out_tile<4>(p, layer, (size_t)b * SU + LC + (size_t)(q >> 3) * 256, q & 7, lds);
    else out_tile<1>(p, layer, (size_t)b * SU + (size_t)((q - 128) >> 3) * 64, q & 7, lds);
  }
}

#define XB_TMO      128
#define XB_XCNT(j)  (256  + 64 * (j))
#define XB_XSUB(j)  (1280 + 64 * (j))
#define XB_XGEN(j)  (2304 + 64 * (j))
#define XB_TOP      3328
#define XB_TOPGEN   3392
#define XCD_BAR_WORDS 3456
#define XB_SPIN_CAP (1u << 18)
#define LAS __attribute__((address_space(3)))

__device__ __forceinline__ unsigned xb_ld(unsigned* p)              { return __hip_atomic_load(p, __ATOMIC_RELAXED, __HIP_MEMORY_SCOPE_AGENT); }
__device__ __forceinline__ unsigned xb_add(unsigned* p, unsigned v) { return __hip_atomic_fetch_add(p, v, __ATOMIC_RELAXED, __HIP_MEMORY_SCOPE_AGENT); }
__device__ __forceinline__ unsigned xb_xcc_id() { return (unsigned)__builtin_amdgcn_s_getreg((3 << 11) | 20) & 0xFu; }
#define XB_SPIN(cond, bar) do { unsigned _sp = 0; while (cond) { __builtin_amdgcn_s_sleep(1); \
    if ((++_sp & 255u) == 0u) { if (xb_ld(&(bar)[XB_TMO])) break; if (_sp > XB_SPIN_CAP) { atomicAdd(&(bar)[XB_TMO], 1u); break; } } } } while (0)

struct XcdBarrier {
    unsigned* bar; unsigned x;
    volatile LAS unsigned* st;
};

__device__ __forceinline__ XcdBarrier xcd_barrier_post(unsigned* bar, volatile LAS unsigned* st) {
    XcdBarrier b; b.bar = bar; b.x = xb_xcc_id(); b.st = st;
    if (threadIdx.x == 0) (void)xb_add(&bar[XB_XCNT(b.x)], 1u);
    return b;
}
__device__ __forceinline__ void xcd_barrier_complete(unsigned* bar, unsigned x, unsigned& nloc, unsigned& nx) {
    const unsigned G = gridDim.x * gridDim.y * gridDim.z;
    unsigned sum, cnt, mine, sp = 0u;
    for (;;) {
        sum = 0u; cnt = 0u; mine = 0u;
#pragma unroll
        for (unsigned j = 0; j < 16; ++j) { const unsigned c = xb_ld(&bar[XB_XCNT(j)]); sum += c; cnt += (c > 0u) ? 1u : 0u; mine = (j == x) ? c : mine; }
        if (sum == G) break;
        __builtin_amdgcn_s_sleep(1);
        if ((++sp & 255u) == 0u) { if (xb_ld(&bar[XB_TMO])) break; if (sp > XB_SPIN_CAP) { atomicAdd(&bar[XB_TMO], 1u); break; } }
    }
    nloc = mine > 0u ? mine : 1u; nx = cnt > 0u ? cnt : 1u;
}

__device__ __forceinline__ void xcd_barrier(const XcdBarrier& b) {
    asm volatile("s_waitcnt vmcnt(0)" ::: "memory");
    __syncthreads();
    if (threadIdx.x == 0) {
        unsigned* bar = b.bar;
        __builtin_amdgcn_s_waitcnt(0);
        unsigned nloc = b.st[0], nx = b.st[1];
        if (nloc == 0u) { xcd_barrier_complete(bar, b.x, nloc, nx); b.st[0] = nloc; b.st[1] = nx; }
        const unsigned old = xb_add(&bar[XB_XSUB(b.x)], 1u);
        const unsigned gen = old / nloc;
        if (old + 1u == (gen + 1u) * nloc) {
            __builtin_amdgcn_fence(__ATOMIC_RELEASE, "agent");
            asm volatile("s_waitcnt vmcnt(0)" ::: "memory");
            const unsigned og = xb_add(&bar[XB_TOP], 1u);
            const unsigned tg = og / nx;
            if (og + 1u == (tg + 1u) * nx) xb_add(&bar[XB_TOPGEN], 1u);
            else XB_SPIN(xb_ld(&bar[XB_TOPGEN]) == tg, bar);
            __builtin_amdgcn_fence(__ATOMIC_ACQUIRE, "agent");
            xb_add(&bar[XB_XGEN(b.x)], 1u);
            asm volatile("s_waitcnt vmcnt(0)" ::: "memory");
        } else {
            XB_SPIN(xb_ld(&bar[XB_XGEN(b.x)]) == gen, bar);
            __builtin_amdgcn_fence(__ATOMIC_ACQUIRE, "agent");
            asm volatile("s_waitcnt vmcnt(0)" ::: "memory");
        }
    }
    __syncthreads();
}

__global__ void __launch_bounds__(256, 2) mega(Params p, int ph_lo, int ph_hi) {
  __shared__ __attribute__((aligned(16))) char lds[65536 + 16];
  volatile LAS unsigned* xst = (volatile LAS unsigned*)(lds + 65544);
  if (threadIdx.x == 0) { xst[0] = 0u; xst[1] = 0u; }
  __syncthreads();
  const XcdBarrier xb = xcd_barrier_post((unsigned*)(p.ws + OFF_SMALL + SM_BAR), xst);
  if (ph_hi == 12345) cg::this_grid().sync();
  for (int ph = ph_lo; ph < ph_hi; ++ph) {
    if (ph == 0) {
      for (int item = blockIdx.x; item < 193 + 3296; item += gridDim.x) {
        if (!(PHM & 1)) continue;
        if (item == 0) misc_item(p);
        else if (item < 193) adaln_item(p, item - 1, lds);
        else weights_item(p, 0, item - 193, lds);
      }
    } else if (ph == 13) {
      if (PHM & 1) final_ln(p);
    } else {
      const int layer = (ph - 1) / 6, sp = (ph - 1) % 6;
      if (sp == 0) {
        if (PHM & 1) ln_rows(p, layer);
        if ((PHM & 1) && layer == 1) for (int item = blockIdx.x; item < 3296; item += gridDim.x) weights_item(p, 1, item, lds);
      } else if (sp == 1) { if (PHM & 2) phase_inproj(p, layer, lds); if (DUPC) { cg::this_grid().sync(); phase_inproj(p, layer, lds); } }
      else if (sp == 2) { if (PHM & 4) phase_mix(p, layer, 0, lds); }
      else if (sp == 3) { if (PHM & 4) phase_mix(p, layer, 1, lds); }
      else if (sp == 4) { if (PHM & 8) phase_merge(p, layer, lds); if (DUPE) { cg::this_grid().sync(); phase_merge(p, layer, lds); } }
      else { if (PHM & 16) phase_out(p, layer, lds); }
    }
    if (ph + 1 < ph_hi) xcd_barrier(xb);
  }
}

extern "C" void kernel_launch(void* const* d_in, const int* in_sizes, int n_in, void* d_out, int out_size, void* d_ws, size_t ws_size,
                              hipStream_t stream) {
  Params p{};
  p.x = (const float*)d_in[0]; p.c = (const float*)d_in[1]; p.ctx = (const float*)d_in[2]; p.c_ctx = (const float*)d_in[3];
  p.w_ada = (const float*)d_in[4]; p.b_ada = (const float*)d_in[5]; p.w_in = (const float*)d_in[6]; p.gla_w_gate = (const float*)d_in[7];
  p.gla_b_gate = (const float*)d_in[8]; p.gla_norm = (const float*)d_in[9]; p.win_sink = (const float*)d_in[10];
  p.glb_q_norm = (const float*)d_in[11]; p.glb_k_norm = (const float*)d_in[12]; p.diff_lambda = (const float*)d_in[13];
  p.diff_norm = (const float*)d_in[14]; p.w_merge = (const float*)d_in[15]; p.w_up = (const float*)d_in[16]; p.w_out = (const float*)d_in[17];
  p.ln_g = (const float*)d_in[18]; p.ln_b = (const float*)d_in[19];
  p.out = (float*)d_out; p.ws = (char*)d_ws;
  if (ws_size < WS_NEED) { fprintf(stderr, "workspace too small: %zu < %zu\n", ws_size, (size_t)WS_NEED); return; }
  static int grid_blocks = 0;
  if (!grid_blocks) {
    int dev = 0, cus = 0, per_cu = 0;
    hipGetDevice(&dev);
    hipDeviceGetAttribute(&cus, hipDeviceAttributeMultiprocessorCount, dev);
    hipOccupancyMaxActiveBlocksPerMultiprocessor(&per_cu, mega, 256, 0);
    if (per_cu > 2) per_cu = 2;
    if (per_cu < 1) per_cu = 1;
    grid_blocks = cus * per_cu;
  }
  hipMemsetAsync((char*)d_ws + OFF_SMALL + SM_BAR, 0, XCD_BAR_WORDS * sizeof(unsigned), stream);
  int lo = 0, hi = 14;
  void* args[] = {&p, &lo, &hi};
  hipError_t e = hipLaunchCooperativeKernel((void*)mega, dim3(grid_blocks), dim3(256), args, 0, stream);
  if (e != hipSuccess) fprintf(stderr, "cooperative launch failed: %s (grid %d)\n", hipGetErrorString(e), grid_blocks);
}
```
